# Optimizing an MI355X kernel written in HIP

```python
import jax
import jax.numpy as jnp
from jax import lax
import numpy as np

D_MODEL = 1024
BATCH = 8
SEQ = 4096
DEPTH = 2

GLA_HEADS = 4
GLA_DK = 64
GLA_DV = 128
GLA_GATE_RANK = 16
GLA_TAU = 16.0
GLA_CHUNK = 64
MLSTM_HEADS = 4
MLSTM_DH = 128
MLSTM_CONV = 4
MLSTM_CHUNK = 64
SB_HEADS = 8
SB_DH = 64
SB_BLOCK = 128
DIL_PAIRS = ((128, 1), (512, 4), (2048, 16))
DIL_HEADS_PER_GROUP = 4
DIL_DH = 64
DIL_HEADS = len(DIL_PAIRS) * DIL_HEADS_PER_GROUP
N_REL_BUCKETS = 32
REL_MAX_DIST = 2048
D_FF = ((8 * D_MODEL + 3 * 256 - 1) // (3 * 256)) * 256
LN_EPS = 1e-5
RES_ALPHA = (2 * DEPTH) ** 0.25
OUT_BETA = (8 * DEPTH) ** -0.25
ADA_SCALE = 0.1
NEG_INF = -1e30
N_EVEN = (DEPTH + 1) // 2
N_ODD = DEPTH // 2

GLA_QK = GLA_HEADS * GLA_DK
GLA_V = GLA_HEADS * GLA_DV
ML_W = MLSTM_HEADS * MLSTM_DH
AB_SPLITS = (GLA_QK, GLA_QK, GLA_V, GLA_V, GLA_GATE_RANK, 2 * ML_W, ML_W, MLSTM_HEADS, MLSTM_HEADS, ML_W)
AB_IN = sum(AB_SPLITS)
AB_OUT = GLA_V + ML_W
SB_W = SB_HEADS * SB_DH
DIL_W = DIL_HEADS * DIL_DH
CD_SPLITS = (SB_W, SB_W, SB_W, DIL_W, DIL_W, DIL_W)
CD_IN = sum(CD_SPLITS)
CD_OUT = SB_W + DIL_HEADS_PER_GROUP * DIL_DH

kernel_name = 'hybrid_gla_mlstm_stickbreak_dilated'


def split_cols(t, sizes):
    idx = [int(s) for s in np.cumsum(sizes)[:-1]]
    return jnp.split(t, idx, axis=-1)


def layer_norm(x, g, b):
    xf = x.astype(jnp.float32)
    mu = jnp.mean(xf, -1, keepdims=True)
    var = jnp.mean(jnp.square(xf - mu), -1, keepdims=True)
    y = (xf - mu) * lax.rsqrt(var + LN_EPS)
    return (y * g.astype(jnp.float32) + b.astype(jnp.float32)).astype(x.dtype)


def head_norm(x, g):
    mu = jnp.mean(x, -1, keepdims=True)
    var = jnp.mean(jnp.square(x - mu), -1, keepdims=True)
    return (x - mu) * lax.rsqrt(var + LN_EPS) * g.astype(jnp.float32).reshape(x.shape[-2], x.shape[-1])


def causal_dwconv(x, w, b):
    k_w, ch = w.shape
    y = lax.conv_general_dilated(x, w.astype(x.dtype)[:, None, :], window_strides=(1,),
                                 padding=((k_w - 1, 0),), dimension_numbers=('NWC', 'WIO', 'NWC'),
                                 feature_group_count=ch)
    return y + b.astype(x.dtype)


def gla_chunked(q, k, v, log_a):
    bsz, s_len, h, dk = q.shape
    dv = v.shape[-1]
    cl = GLA_CHUNK
    nc = s_len // cl
    q, k, v, log_a = [t.reshape(bsz, nc, cl, h, t.shape[-1]) for t in (q, k, v, log_a)]
    b = jnp.cumsum(log_a, axis=2)
    b_last = b[:, :, -1]
    q_in = q * jnp.exp(b)
    k_in = k * jnp.exp(-b)
    tril = np.tril(np.ones((cl, cl), dtype=bool))
    scores = jnp.where(tril, jnp.einsum('bnihk,bnjhk->bnhij', q_in, k_in), 0.0)
    o_intra = jnp.einsum('bnhij,bnjhv->bnihv', scores, v)
    kv_chunk = jnp.einsum('bnjhk,bnjhv->bnhkv', k * jnp.exp(b_last[:, :, None] - b), v)
    decay = jnp.exp(b_last)

    def step(state, inp):
        dec, kv = inp
        return dec[..., None] * state + kv, state

    init = jnp.zeros((bsz, h, dk, dv), jnp.float32)
    _, s_before = lax.scan(step, init, (jnp.moveaxis(decay, 1, 0), jnp.moveaxis(kv_chunk, 1, 0)))
    o_inter = jnp.einsum('bnihk,nbhkv->bnihv', q_in, s_before)
    return (o_intra + o_inter).reshape(bsz, s_len, h, dv)


def mlstm_chunked(q, k, v, i_pre, log_f):
    bsz, s_len, h, d = q.shape
    cl = MLSTM_CHUNK
    nc = s_len // cl
    q, k, v = [t.reshape(bsz, nc, cl, h, d) for t in (q, k, v)]
    i_pre, log_f = [t.reshape(bsz, nc, cl, h) for t in (i_pre, log_f)]
    b = jnp.cumsum(log_f, axis=2)
    b_last = b[:, :, -1]
    tril = np.tril(np.ones((cl, cl), dtype=bool))[:, :, None]
    d_log = jnp.where(tril, b[:, :, :, None, :] - b[:, :, None, :, :] + i_pre[:, :, None, :, :], NEG_INF)
    w_end = b_last[:, :, None, :] - b + i_pre

    def step(carry, inp):
        c_bar, n_bar, m = carry
        k_c, v_c, w_c, bl = inp
        m_new = jnp.maximum(bl + m, jnp.max(w_c, axis=1))
        sc = jnp.exp(bl + m - m_new)
        wj = jnp.exp(w_c - m_new[:, None, :])
        c_new = sc[..., None, None] * c_bar + jnp.einsum('bjh,bjhv,bjhk->bhvk', wj, v_c, k_c)
        n_new = sc[..., None] * n_bar + jnp.einsum('bjh,bjhk->bhk', wj, k_c)
        return (c_new, n_new, m_new), (c_bar, n_bar, m)

    init = (jnp.zeros((bsz, h, d, d), jnp.float32), jnp.zeros((bsz, h, d), jnp.float32),
            jnp.zeros((bsz, h), jnp.float32))
    xs = (jnp.moveaxis(k, 1, 0), jnp.moveaxis(v, 1, 0), jnp.moveaxis(w_end, 1, 0), jnp.moveaxis(b_last, 1, 0))
    _, (c_prev, n_prev, m_prev) = lax.scan(step, init, xs)
    inter_log = b + jnp.moveaxis(m_prev, 0, 1)[:, :, None, :]
    m_i = jnp.maximum(inter_log, jnp.max(d_log, axis=3))
    w_intra = jnp.exp(d_log - m_i[:, :, :, None, :])
    s_inter = jnp.exp(inter_log - m_i)
    a = w_intra * jnp.einsum('bnihd,bnjhd->bnijh', q, k)
    num = jnp.einsum('bnijh,bnjhd->bnihd', a, v) + s_inter[..., None] * jnp.einsum('bnihk,nbhvk->bnihv', q, c_prev)
    den = jnp.sum(a, axis=3) + s_inter * jnp.einsum('bnihk,nbhk->bnih', q, n_prev)
    hid = num / jnp.maximum(jnp.abs(den), jnp.exp(-m_i))[..., None]
    return hid.reshape(bsz, s_len, h, d)


def stick_breaking(q, k, v):
    bsz, s_len, h, dh = q.shape
    nq = s_len // SB_BLOCK
    scale = dh ** -0.5
    qb = q.reshape(bsz, nq, SB_BLOCK, h, dh).transpose(1, 0, 2, 3, 4)
    s_pos = jnp.arange(s_len)

    def block(args):
        q_blk, i = args
        z = jnp.einsum('bqhd,bkhd->bhqk', q_blk, k) * scale
        t_pos = i * SB_BLOCK + jnp.arange(SB_BLOCK)
        causal = s_pos[None, :] < t_pos[:, None]
        log_1m = jnp.where(causal, jax.nn.log_sigmoid(-z), 0.0)
        suffix = lax.cumsum(log_1m, axis=3, reverse=True)
        excl = jnp.pad(suffix[..., 1:], ((0, 0), (0, 0), (0, 0), (0, 1)))
        att = jnp.where(causal, jnp.exp(jax.nn.log_sigmoid(z) + excl), 0.0)
        return jnp.einsum('bhqk,bkhd->bqhd', att, v)

    out = lax.map(block, (qb, jnp.arange(nq)))
    return out.transpose(1, 0, 2, 3, 4).reshape(bsz, s_len, h, dh)


def t5_bucket(dist):
    max_exact = N_REL_BUCKETS // 2
    dd = np.maximum(dist, 1).astype(np.float64)
    large = max_exact + (np.log(dd / max_exact) / np.log(REL_MAX_DIST / max_exact)
                         * (N_REL_BUCKETS - max_exact)).astype(np.int32)
    large = np.minimum(large, N_REL_BUCKETS - 1)
    return np.where(dist < max_exact, dist, large).astype(np.int32)


def dilated_group(q, k, v, bias_tab, window, dil):
    bsz, s_len, h, dh = q.shape
    blk = window // dil
    unit = blk * dil
    sp = -(-s_len // unit) * unit
    n_sub = sp // dil
    nb = n_sub // blk

    def to_sub(t):
        t = jnp.pad(t, ((0, 0), (0, sp - s_len), (0, 0), (0, 0)))
        t = t.reshape(bsz, n_sub, dil, h, dh).transpose(0, 2, 1, 3, 4)
        return t.reshape(bsz, dil, nb, blk, h, dh)

    def with_prev(t):
        prev = jnp.pad(t[:, :, :-1], ((0, 0), (0, 0), (1, 0), (0, 0), (0, 0), (0, 0)))
        return jnp.concatenate([prev, t], axis=3)

    qs = to_sub(q)
    kk = with_prev(to_sub(k))
    vv = with_prev(to_sub(v))
    qi = np.arange(blk)[:, None]
    kj = np.arange(2 * blk)[None, :]
    delta = qi - kj + blk
    in_win = (delta >= 0) & (delta <= blk)
    valid = in_win[None] & ((np.arange(nb)[:, None, None] > 0) | (kj[None] >= blk))
    bucket = t5_bucket(np.clip(delta, 0, None) * dil)
    bias = jnp.transpose(bias_tab[bucket].astype(jnp.float32), (2, 0, 1))
    logits = jnp.einsum('brnqhd,brnkhd->brnhqk', qs, kk) * dh ** -0.5 + bias
    logits = jnp.where(valid[:, None], logits, NEG_INF)
    m = jnp.max(logits, axis=-1, keepdims=True)
    p = jnp.exp(logits - m)
    den = jnp.sum(p, axis=-1)
    o = jnp.einsum('brnhqk,brnkhd->brnqhd', p, vv) / jnp.swapaxes(den, -1, -2)[..., None]
    lse = jnp.swapaxes(m[..., 0] + jnp.log(den), -1, -2)

    def from_sub(t):
        rest = t.shape[4:]
        t = jnp.swapaxes(t.reshape((bsz, dil, n_sub) + rest), 1, 2)
        return t.reshape((bsz, sp) + rest)[:, :s_len]

    return from_sub(o), from_sub(lse)


def dilated_mixture(q, k, v, rel_bias):
    outs, lses = [], []
    for g, (window, dil) in enumerate(DIL_PAIRS):
        tab = rel_bias[:, g * DIL_HEADS_PER_GROUP:(g + 1) * DIL_HEADS_PER_GROUP]
        o, l = dilated_group(q[:, :, g], k[:, :, g], v[:, :, g], tab, window, dil)
        outs.append(o)
        lses.append(l)
    wts = jax.nn.softmax(jnp.stack(lses, 0), axis=0)
    return jnp.sum(wts[..., None] * jnp.stack(outs, 0), axis=0)


def gla_mlstm_mixer(h, w_in, wa_up, ba, gla_g, conv_w, conv_b, b_i, b_f, ml_g, w_out):
    bsz, s_len, _ = h.shape
    proj = (h @ w_in).astype(jnp.float32)
    qa, ka, va, ra, aa, qkb, vb, ib, fb, ob = split_cols(proj, AB_SPLITS)
    qa = qa.reshape(bsz, s_len, GLA_HEADS, GLA_DK) * GLA_DK ** -0.5
    ka = ka.reshape(bsz, s_len, GLA_HEADS, GLA_DK)
    va = va.reshape(bsz, s_len, GLA_HEADS, GLA_DV)
    log_a = jax.nn.log_sigmoid(aa @ wa_up.astype(jnp.float32) + ba.astype(jnp.float32)) / GLA_TAU
    oa = gla_chunked(qa, ka, va, log_a.reshape(bsz, s_len, GLA_HEADS, GLA_DK))
    oa = (head_norm(oa, gla_g).reshape(bsz, s_len, GLA_V)) * jax.nn.silu(ra)
    qkb = jax.nn.silu(causal_dwconv(qkb, conv_w, conv_b))
    qb_, kb_ = jnp.split(qkb, 2, axis=-1)
    qb_ = qb_.reshape(bsz, s_len, MLSTM_HEADS, MLSTM_DH)
    kb_ = kb_.reshape(bsz, s_len, MLSTM_HEADS, MLSTM_DH) * MLSTM_DH ** -0.5
    vb = vb.reshape(bsz, s_len, MLSTM_HEADS, MLSTM_DH)
    i_pre = ib + b_i.astype(jnp.float32)
    log_f = jax.nn.log_sigmoid(fb + b_f.astype(jnp.float32))
    hb = mlstm_chunked(qb_, kb_, vb, i_pre, log_f)
    hb = jax.nn.sigmoid(ob) * head_norm(hb, ml_g).reshape(bsz, s_len, ML_W)
    y = jnp.concatenate([oa, hb], axis=-1) @ w_out
    return y.astype(h.dtype)


def sb_dilated_mixer(h, w_in, rel_bias, w_out):
    bsz, s_len, _ = h.shape
    proj = (h @ w_in).astype(jnp.float32)
    qc, kc, vc, qd, kd, vd = split_cols(proj, CD_SPLITS)
    hc = lambda t: t.reshape(bsz, s_len, SB_HEADS, SB_DH)
    oc = stick_breaking(hc(qc), hc(kc), hc(vc)).reshape(bsz, s_len, SB_W)
    hd = lambda t: t.reshape(bsz, s_len, len(DIL_PAIRS), DIL_HEADS_PER_GROUP, DIL_DH)
    od = dilated_mixture(hd(qd), hd(kd), hd(vd), rel_bias).reshape(bsz, s_len, DIL_HEADS_PER_GROUP * DIL_DH)
    y = jnp.concatenate([oc, od], axis=-1) @ w_out
    return y.astype(h.dtype)


def swiglu(h, w1, w3, w2):
    return (jax.nn.silu(h @ w1) * (h @ w3)) @ w2


def setup_inputs(seed: int = 0) -> dict:
    key = jax.random.key(seed)
    ks = jax.random.split(key, 22)
    nrm = lambda k, shape, s: jax.random.normal(k, shape, jnp.float32) * s
    d = D_MODEL
    return {
        'x': nrm(ks[0], (BATCH, SEQ, d), 1.0),
        'c': nrm(ks[1], (BATCH, d), 1.0),
        'ada_w': nrm(ks[2], (DEPTH, d, 6 * d), ADA_SCALE * d ** -0.5),
        'ada_b': nrm(ks[3], (DEPTH, 6 * d), 0.01),
        'ln_g': 1.0 + nrm(ks[4], (DEPTH, 2, d), 0.02),
        'ln_b': nrm(ks[5], (DEPTH, 2, d), 0.02),
        'ab_w_in': nrm(ks[6], (N_EVEN, d, AB_IN), d ** -0.5),
        'gla_wa_up': nrm(ks[7], (N_EVEN, GLA_GATE_RANK, GLA_QK), GLA_GATE_RANK ** -0.5),
        'gla_ba': nrm(ks[8], (N_EVEN, GLA_QK), 0.1),
        'gla_norm_g': 1.0 + nrm(ks[9], (N_EVEN, GLA_V), 0.02),
        'ml_conv_w': nrm(ks[10], (N_EVEN, MLSTM_CONV, 2 * ML_W), MLSTM_CONV ** -0.5),
        'ml_conv_b': nrm(ks[11], (N_EVEN, 2 * ML_W), 0.01),
        'ml_b_i': nrm(ks[12], (N_EVEN, MLSTM_HEADS), 0.1),
        'ml_b_f': jnp.linspace(3.0, 6.0, MLSTM_HEADS)[None, :] + nrm(ks[13], (N_EVEN, MLSTM_HEADS), 0.1),
        'ml_norm_g': 1.0 + nrm(ks[14], (N_EVEN, ML_W), 0.02),
        'ab_w_out': nrm(ks[15], (N_EVEN, AB_OUT, d), OUT_BETA * AB_OUT ** -0.5),
        'cd_w_in': nrm(ks[16], (N_ODD, d, CD_IN), d ** -0.5),
        'rel_bias': nrm(ks[17], (N_REL_BUCKETS, DIL_HEADS), 0.5),
        'cd_w_out': nrm(ks[18], (N_ODD, CD_OUT, d), OUT_BETA * CD_OUT ** -0.5),
        'ffn_w1': nrm(ks[19], (DEPTH, d, D_FF), d ** -0.5),
        'ffn_w3': nrm(ks[20], (DEPTH, d, D_FF), d ** -0.5),
        'ffn_w2': nrm(ks[21], (DEPTH, D_FF, d), OUT_BETA * D_FF ** -0.5),
    }


def reference(x, c, ada_w, ada_b, ln_g, ln_b, ab_w_in, gla_wa_up, gla_ba, gla_norm_g, ml_conv_w, ml_conv_b,
              ml_b_i, ml_b_f, ml_norm_g, ab_w_out, cd_w_in, rel_bias, cd_w_out, ffn_w1, ffn_w3, ffn_w2):
    c_act = jax.nn.silu(c)
    for layer in range(DEPTH):
        mod = c_act @ ada_w[layer] + ada_b[layer]
        sh_m, sc_m, g_m, sh_f, sc_f, g_f = [t[:, None, :] for t in jnp.split(mod, 6, axis=-1)]
        hm = x * (1.0 + sc_m) + sh_m
        j = layer // 2
        if layer % 2 == 0:
            y = gla_mlstm_mixer(hm, ab_w_in[j], gla_wa_up[j], gla_ba[j], gla_norm_g[j], ml_conv_w[j], ml_conv_b[j],
                                ml_b_i[j], ml_b_f[j], ml_norm_g[j], ab_w_out[j])
        else:
            y = sb_dilated_mixer(hm, cd_w_in[j], rel_bias, cd_w_out[j])
        x = layer_norm(RES_ALPHA * x + (1.0 + g_m) * y, ln_g[layer, 0], ln_b[layer, 0])
        hf = x * (1.0 + sc_f) + sh_f
        yf = swiglu(hf, ffn_w1[layer], ffn_w3[layer], ffn_w2[layer])
        x = layer_norm(RES_ALPHA * x + (1.0 + g_f) * yf, ln_g[layer, 1], ln_b[layer, 1])
    return x
```

```cpp
#include <hip/hip_runtime.h>
#include <cstdio>
#include <cstdint>
#ifndef MK_N_LAUNCHES
#define MK_N_LAUNCHES 1
#endif
namespace pg8 {
#define PG8_LAS __attribute__((address_space(3)))
typedef unsigned short bf16_t;
typedef short bf16x8 __attribute__((ext_vector_type(8)));
typedef float f32x4 __attribute__((ext_vector_type(4)));
typedef unsigned u32x4 __attribute__((ext_vector_type(4)));
constexpr int BM = 256, BK = 64, HALF = 128, HTB = HALF * BK * 2  , STAGE_BYTES = 8 * HTB, NXCD = 8, WGM = 8;

__host__ __device__ __forceinline__ int lds_byte(int r, int c) { const int st = (r >> 4) * 2 + (c >> 5), rr = r & 15, cc = c & 31, ob = rr * 64 + cc * 2; return st * 1024 + (ob ^ (((ob >> 9) & 1) << 5)); }
__host__ __device__ __forceinline__ void stage_rc(int b, int& R, int& C) { const int st = b / 1024, sb = b % 1024, swz = sb ^ (((sb >> 9) & 1) << 5); R = (st >> 1) * 16 + swz / 64; C = (st & 1) * 32 + (swz % 64) / 2; }
__host__ __device__ __forceinline__ int perm32(int rho) { const int n = rho >> 4, i = rho & 15; return 8 * (i >> 2) + 4 * n + (i & 3); }

struct Unit { int pm, pn; };
struct Gemm { const bf16_t* A; const bf16_t* Bt; int M, N, K; };

struct StaticOrder {
    int nM, nN, nwg, G, c;
    __host__ __device__ void init(int M, int N, int G_, int c_) { nM = M / BM; nN = N / BM; nwg = nM * nN; G = G_; c = c_; }
    __host__ __device__ bool next(int i, Unit& u) const {
        const long L = (long)i * G + c; if (L >= nwg) return false;
        int wgid = (int)L; { const int q = nwg / NXCD, r = nwg % NXCD, xcd = wgid % NXCD, off = wgid / NXCD; wgid = (xcd < r ? xcd * (q + 1) : r * (q + 1) + (xcd - r) * q) + off; }
        const int nig = WGM * nN, gid = wgid / nig, fm = gid * WGM, gsz = (nM - fm) < WGM ? (nM - fm) : WGM;
        u.pm = fm + ((wgid % nig) % gsz); u.pn = (wgid % nig) / gsz; return true;
    }
    __device__ __forceinline__ void a_ready(const Unit&) const {}
    __device__ __forceinline__ void done(const Unit&) const {}
};

__device__ __forceinline__ unsigned cvt_pk_bf16(float lo, float hi) { unsigned r; asm volatile("v_cvt_pk_bf16_f32 %0, %1, %2" : "=v"(r) : "v"(lo), "v"(hi)); return r; }
typedef float f32x2 __attribute__((ext_vector_type(2)));
struct EpiBf16S {
    static constexpr bool PERM = true, AFTER_DRAIN = false;
    bf16_t* O; int ldc; unsigned scale_mask;
    __device__ __forceinline__ void operator()(const f32x4 (&acc)[2][2][4][2], const Unit& u, int wr, int wc, int fr, int fq) const {
        const int row0 = u.pm * BM + wr * 64 + fr, col0 = u.pn * BM + wc * 32 + 8 * fq;
        const float sc = ((scale_mask >> u.pn) & 1u) ? 0.125f : 1.0f;
#pragma unroll
        for (int ai = 0; ai < 2; ++ai)
#pragma unroll
            for (int m = 0; m < 4; ++m) { bf16_t* rowp = O + (size_t)(row0 + ai * HALF + m * 16) * ldc + col0;
#pragma unroll
                for (int bj = 0; bj < 2; ++bj) { const f32x4 v0 = acc[ai][bj][m][0] * sc, v1 = acc[ai][bj][m][1] * sc;
                    u32x4 w; w.x = cvt_pk_bf16(v0[0], v0[1]); w.y = cvt_pk_bf16(v0[2], v0[3]); w.z = cvt_pk_bf16(v1[0], v1[1]); w.w = cvt_pk_bf16(v1[2], v1[3]);
                    *(u32x4*)(rowp + bj * HALF) = w; } }
    }
};
__device__ __forceinline__ float silu_f(float x) { return x * __builtin_amdgcn_rcpf(1.0f + __builtin_amdgcn_exp2f(-1.4426950408889634f * x)); }
struct EpiSwiglu {
    static constexpr bool PERM = true, AFTER_DRAIN = false;
    bf16_t* G; int ldg;
    __device__ __forceinline__ void operator()(const f32x4 (&acc)[2][2][4][2], const Unit& u, int wr, int wc, int fr, int fq) const {
        const int row0 = u.pm * BM + wr * 64 + fr, col0 = u.pn * HALF + wc * 32 + 8 * fq;
#pragma unroll
        for (int ai = 0; ai < 2; ++ai)
#pragma unroll
            for (int m = 0; m < 4; ++m) { bf16_t* rowp = G + (size_t)(row0 + ai * HALF + m * 16) * ldg + col0;
                float g[8];
#pragma unroll
                for (int n = 0; n < 2; ++n)
#pragma unroll
                    for (int i = 0; i < 4; ++i) g[4 * n + i] = silu_f(acc[ai][0][m][n][i]) * acc[ai][1][m][n][i];
                u32x4 w; w.x = cvt_pk_bf16(g[0], g[1]); w.y = cvt_pk_bf16(g[2], g[3]); w.z = cvt_pk_bf16(g[4], g[5]); w.w = cvt_pk_bf16(g[6], g[7]);
                *(u32x4*)rowp = w; }
    }
};
struct EpiRes {
    static constexpr bool PERM = false, AFTER_DRAIN = false;
    const float* src; float* U; const float* stats; const float* lng; const float* lnb; const float* gate; float alpha;
    __device__ __forceinline__ void operator()(const f32x4 (&acc)[2][2][4][2], const Unit& u, int wr, int wc, int fr, int fq) const {
        const int cb = u.pn * BM + wc * 32 + 4 * fq;
        const float* gt = gate + (size_t)(u.pm >> 4) * 6144;
#pragma unroll
        for (int ai = 0; ai < 2; ++ai)
#pragma unroll
            for (int m = 0; m < 4; ++m) { const int row = u.pm * BM + ai * HALF + wr * 64 + m * 16 + fr;
                float mean = 0.f, rstd = 1.f; if (stats) { mean = stats[2 * row]; rstd = stats[2 * row + 1]; }
#pragma unroll
                for (int bj = 0; bj < 2; ++bj)
#pragma unroll
                    for (int n = 0; n < 2; ++n) { const int col = cb + bj * HALF + n * 16; const size_t off = (size_t)row * 1024 + col;
                        f32x4 r4 = *(const f32x4*)(src + off);
                        if (stats) { const f32x4 g4 = *(const f32x4*)(lng + col), b4 = *(const f32x4*)(lnb + col); r4 = (r4 - mean) * rstd * g4 + b4; }
                        const f32x4 g1 = *(const f32x4*)(gt + col) + 1.0f;
                        *(f32x4*)(U + off) = r4 * alpha + g1 * acc[ai][bj][m][n]; }
                asm volatile("" ::: "memory"); }
    }
};
template <class Epi, class Sched, bool ALIGN_EPI = false, bool SP2 = false>
__device__ __forceinline__ void gemm_phase(PG8_LAS unsigned char* lds, const Gemm g, const Sched& S, const Epi& E) {
    const int tid = threadIdx.x, wid = __builtin_amdgcn_readfirstlane(tid >> 6), lane = tid & 63, wr = wid >> 2, wc = wid & 3, fr = lane & 15, fq = lane >> 4;
    const int K = g.K, nt = K / BK;
    unsigned voffA[2], voffB[2];
#pragma unroll
    for (int i = 0; i < 2; ++i) { int R, C; stage_rc(tid * 16 + i * 8192, R, C); const int Rb = Epi::PERM ? ((R & ~31) + perm32(R & 31)) : R;
        voffA[i] = (unsigned)(R * K + C) * 2u; voffB[i] = (unsigned)(Rb * K + C) * 2u; }
    const size_t kstep = (size_t)(BK * 2);
    const size_t hstep = (size_t)HALF * K * 2;
    const size_t tstep = 2 * hstep;
    const unsigned ldsw = (unsigned)wid * 1024u;
    const int aoff = lds_byte(wr * 64 + fr, fq * 8), boff = lds_byte(wc * 32 + fr, fq * 8);
#define PG8_SA(b, h) (((b) * 2 + (h)) * HTB)
#define PG8_SB(b, h) ((4 + (b) * 2 + (h)) * HTB)
#define PG8_STAGE(bufoff, gbase, voff) do { _Pragma("unroll") for (int _i = 0; _i < 2; ++_i) \
        __builtin_amdgcn_global_load_lds((const unsigned*)((const char*)(gbase) + (voff)[_i]), (PG8_LAS unsigned*)(lds + (bufoff) + ldsw + _i * 8192), 16, 0, 0); } while (0)
#define PG8_LDA(dst, b, h) do { _Pragma("unroll") for (int m = 0; m < 4; ++m) _Pragma("unroll") for (int k = 0; k < 2; ++k) dst[m][k] = *(const PG8_LAS bf16x8*)(lds + PG8_SA(b, h) + aoff + m * 2048 + k * 1024); } while (0)
#define PG8_LDB(dst, b, h) do { _Pragma("unroll") for (int n = 0; n < 2; ++n) _Pragma("unroll") for (int k = 0; k < 2; ++k) dst[n][k] = *(const PG8_LAS bf16x8*)(lds + PG8_SB(b, h) + boff + n * 2048 + k * 1024); } while (0)
#define PG8_MMA(ai, bj, At, Bt) do { __builtin_amdgcn_s_setprio(1); _Pragma("unroll") for (int m = 0; m < 4; ++m) _Pragma("unroll") for (int n = 0; n < 2; ++n) _Pragma("unroll") for (int k = 0; k < 2; ++k) \
        acc[ai][bj][m][n] = __builtin_amdgcn_mfma_f32_16x16x32_bf16(Bt[n][k], At[m][k], acc[ai][bj][m][n], 0, 0, 0); __builtin_amdgcn_s_setprio(0); } while (0)
#define PG8_WAIT_V(n) asm volatile("s_waitcnt vmcnt(" #n ")" ::: "memory")
#define PG8_WAIT_L(n) asm volatile("s_waitcnt lgkmcnt(" #n ")" ::: "memory")
#define PG8_BAR __builtin_amdgcn_s_barrier()
#define PG8_SCHED __builtin_amdgcn_sched_barrier(0)
    Unit cur, nxt; int ui = 0;
    if (!S.next(0, cur)) return;
    f32x4 acc[2][2][4][2];
#pragma unroll
    for (int a = 0; a < 2; ++a)
#pragma unroll
        for (int b = 0; b < 2; ++b)
#pragma unroll
            for (int m = 0; m < 4; ++m)
#pragma unroll
                for (int n = 0; n < 2; ++n) acc[a][b][m][n] = (f32x4){0.f, 0.f, 0.f, 0.f};
    bf16x8 At[4][2], B0[2][2], B1[2][2];
    const char* cA = (const char*)g.A + (size_t)cur.pm * tstep; const char* cB = (const char*)g.Bt + (size_t)cur.pn * tstep;
    S.a_ready(cur);
    if constexpr (SP2) {
        PG8_STAGE(PG8_SB(0, 0), cB, voffB); PG8_STAGE(PG8_SB(0, 1), cB + hstep, voffB); PG8_STAGE(PG8_SA(0, 0), cA, voffA); PG8_STAGE(PG8_SA(0, 1), cA + hstep, voffA);
        if (wr == 1) PG8_BAR;
        PG8_WAIT_V(2); PG8_BAR;
        PG8_STAGE(PG8_SB(1, 0), cB + kstep, voffB); PG8_STAGE(PG8_SA(1, 0), cA + kstep, voffA); PG8_STAGE(PG8_SB(1, 1), cB + hstep + kstep, voffB);
        PG8_WAIT_V(6); PG8_BAR;
    } else {
        PG8_STAGE(PG8_SB(0, 0), cB, voffB); PG8_STAGE(PG8_SA(0, 0), cA, voffA); PG8_STAGE(PG8_SB(0, 1), cB + hstep, voffB); PG8_STAGE(PG8_SA(0, 1), cA + hstep, voffA);
        if (wr == 1) PG8_BAR;
        PG8_WAIT_V(4); PG8_BAR;
        PG8_STAGE(PG8_SB(1, 0), cB + kstep, voffB); PG8_STAGE(PG8_SA(1, 0), cA + kstep, voffA); PG8_STAGE(PG8_SB(1, 1), cB + hstep + kstep, voffB);
        PG8_WAIT_V(6); PG8_BAR;
    }
    for (;;) {
        const bool has_next = S.next(ui + 1, nxt);
        const char* nA = has_next ? (const char*)g.A + (size_t)nxt.pm * tstep : cA; const char* nB = has_next ? (const char*)g.Bt + (size_t)nxt.pn * tstep : cB;
        for (int t = 0; t < nt; t += 2) {
            const bool last = (t == nt - 2);
            const char* a1 = cA + (size_t)(t + 1) * kstep;
            const char* a2 = last ? nA : cA + (size_t)(t + 2) * kstep; const char* b2 = last ? nB : cB + (size_t)(t + 2) * kstep;
            const char* a3 = a2 + kstep; const char* b3 = b2 + kstep;
            if (last && has_next) S.a_ready(nxt);
            if constexpr (SP2) {
            PG8_LDB(B0, 0, 0); PG8_LDB(B1, 0, 1); PG8_SCHED; PG8_LDA(At, 0, 0); PG8_STAGE(PG8_SA(1, 1), a1 + hstep, voffA);
            PG8_WAIT_V(8); PG8_WAIT_L(0); PG8_BAR; PG8_MMA(0, 0, At, B0); PG8_MMA(0, 1, At, B1); PG8_BAR; PG8_SCHED;
            PG8_LDA(At, 0, 1); PG8_STAGE(PG8_SB(0, 0), b2, voffB); PG8_STAGE(PG8_SB(0, 1), b2 + hstep, voffB); PG8_STAGE(PG8_SA(0, 0), a2, voffA);
            PG8_WAIT_V(8); PG8_WAIT_L(0); PG8_BAR; PG8_MMA(1, 0, At, B0); PG8_MMA(1, 1, At, B1); PG8_BAR; PG8_SCHED;
            PG8_LDB(B0, 1, 0); PG8_LDB(B1, 1, 1); PG8_SCHED; PG8_LDA(At, 1, 0); PG8_STAGE(PG8_SA(0, 1), a2 + hstep, voffA);
            PG8_WAIT_V(8); PG8_WAIT_L(0); PG8_BAR; PG8_MMA(0, 0, At, B0); PG8_MMA(0, 1, At, B1); PG8_BAR; PG8_SCHED;
            PG8_LDA(At, 1, 1); PG8_STAGE(PG8_SB(1, 0), b3, voffB); PG8_STAGE(PG8_SB(1, 1), b3 + hstep, voffB); PG8_STAGE(PG8_SA(1, 0), a3, voffA);
            PG8_WAIT_V(8); PG8_WAIT_L(0); PG8_BAR; PG8_MMA(1, 0, At, B0); PG8_MMA(1, 1, At, B1); PG8_BAR; PG8_SCHED;
            } else {
            PG8_LDB(B0, 0, 0); PG8_SCHED; PG8_LDA(At, 0, 0); PG8_STAGE(PG8_SA(1, 1), a1 + hstep, voffA);
            PG8_WAIT_L(8); PG8_BAR; PG8_WAIT_L(0); PG8_MMA(0, 0, At, B0); PG8_BAR; PG8_SCHED;
            PG8_LDB(B1, 0, 1); PG8_STAGE(PG8_SB(0, 0), b2, voffB);
            PG8_BAR; PG8_WAIT_L(0); PG8_MMA(0, 1, At, B1); PG8_BAR;
            PG8_LDA(At, 0, 1); PG8_STAGE(PG8_SA(0, 0), a2, voffA);
            PG8_BAR; PG8_WAIT_L(0); PG8_MMA(1, 0, At, B0); PG8_BAR; PG8_SCHED;
            PG8_STAGE(PG8_SB(0, 1), b2 + hstep, voffB);
            PG8_WAIT_V(6); PG8_BAR; PG8_MMA(1, 1, At, B1); PG8_BAR;
            PG8_LDB(B0, 1, 0); PG8_SCHED; PG8_LDA(At, 1, 0); PG8_STAGE(PG8_SA(0, 1), a2 + hstep, voffA);
            PG8_WAIT_L(8); PG8_BAR; PG8_WAIT_L(0); PG8_MMA(0, 0, At, B0); PG8_BAR; PG8_SCHED;
            PG8_LDB(B1, 1, 1); PG8_STAGE(PG8_SB(1, 0), b3, voffB);
            PG8_BAR; PG8_WAIT_L(0); PG8_MMA(0, 1, At, B1); PG8_BAR;
            PG8_LDA(At, 1, 1); PG8_STAGE(PG8_SA(1, 0), a3, voffA);
            PG8_BAR; PG8_WAIT_L(0); PG8_MMA(1, 0, At, B0); PG8_BAR; PG8_SCHED;
            PG8_STAGE(PG8_SB(1, 1), b3 + hstep, voffB);
            PG8_WAIT_V(6); PG8_BAR; PG8_MMA(1, 1, At, B1); PG8_BAR;
            }
        }
        if constexpr (ALIGN_EPI) { if (wr == 0) PG8_BAR; }
        if constexpr (!Epi::AFTER_DRAIN) { E(acc, cur, wr, wc, fr, fq); S.done(cur); }
        if (!has_next) break;
#pragma unroll
        for (int a = 0; a < 2; ++a)
#pragma unroll
            for (int b = 0; b < 2; ++b)
#pragma unroll
                for (int m = 0; m < 4; ++m)
#pragma unroll
                    for (int n = 0; n < 2; ++n) acc[a][b][m][n] = (f32x4){0.f, 0.f, 0.f, 0.f};
        cur = nxt; cA = nA; cB = nB; ++ui;
        if constexpr (ALIGN_EPI) { if (wr == 1) PG8_BAR; }
    }
    PG8_WAIT_V(0);
    if constexpr (!ALIGN_EPI) { if (wr == 0) PG8_BAR; }
    PG8_BAR;
    if constexpr (Epi::AFTER_DRAIN) { E.fused(acc, cur, wr, wc, fr, fq, lds, wid, lane); S.done(cur); }
#undef PG8_SA
#undef PG8_SB
#undef PG8_STAGE
#undef PG8_LDA
#undef PG8_LDB
#undef PG8_MMA
#undef PG8_WAIT_V
#undef PG8_WAIT_L
#undef PG8_BAR
#undef PG8_SCHED
}
}
constexpr int NWAVES = 8;
constexpr int N_LAUNCHES = MK_N_LAUNCHES;
constexpr int BATCH = 8, SEQ = 4096, T = BATCH * SEQ, D = 1024, FF = 2816;
constexpr int NAB = 3584, NCD = 3840, NFF2 = 2 * FF, CDO = 768;
constexpr int AB_IN = 3608;
constexpr float LN_EPS = 1e-5f, RES_ALPHA = 1.41421356237309515f;
constexpr int NPHASE = 18;
constexpr int C_QA = 0, C_KA = 256, C_VA = 512, C_RA = 1024, C_QKB = 1536, C_VB = 2560, C_OB = 3072;
constexpr int C_QC = 0, C_KC = 512, C_VC = 1024, C_QD = 1536, C_KD = 2304, C_VD = 3072;
constexpr int MO_SHM = 0, MO_SCM = 1024, MO_GM = 2048, MO_SHF = 3072, MO_SCF = 4096, MO_GF = 5120;

constexpr size_t MiB = 1u << 20;
constexpr size_t WS_CTL = 0, CTL_ZERO_BYTES = 1 * MiB;
constexpr size_t WS_MOD = 1 * MiB;
constexpr size_t WS_STATS = 1 * MiB + 512 * 1024;
constexpr size_t WS_DEN = 2 * MiB;
constexpr size_t WS_G24 = 3 * MiB;
constexpr size_t WS_WAB = 8 * MiB;
constexpr size_t WS_WABO = 15 * MiB;
constexpr size_t WS_WCD = 17 * MiB;
constexpr size_t WS_WCDO = 24 * MiB + 512 * 1024;
constexpr size_t WS_W13 = 26 * MiB;
constexpr size_t WS_W2 = 48 * MiB;
constexpr size_t WS_XN = 60 * MiB;
constexpr size_t WS_MIX = 124 * MiB;
constexpr size_t WS_BIG = 188 * MiB;
constexpr size_t WS_ADEC = 428 * MiB;
constexpr size_t WS_END = 460 * MiB;
constexpr int CW_BAR = 4096;

constexpr int RING_OFF = 0, RING_BYTES = 131072;
constexpr int LDSCTL_OFF = RING_BYTES, MISC_OFF = LDSCTL_OFF + 320;
constexpr int LDS_BYTES = 147456;

__device__ const unsigned char BUCKET[3][132] = {
 {0,1,2,3,4,5,6,7,8,9,10,11,12,13,14,15,16,16,16,16,16,16,17,17,17,17,17,17,17,17,18,18,18,18,18,18,18,18,18,18,19,19,19,19,19,19,19,19,19,19,19,19,19,19,20,20,20,20,20,20,20,20,20,20,20,20,20,20,20,20,20,20,20,21,21,21,21,21,21,21,21,21,21,21,21,21,21,21,21,21,21,21,21,21,21,21,21,21,21,22,22,22,22,22,22,22,22,22,22,22,22,22,22,22,22,22,22,22,22,22,22,22,22,22,22,22,22,22,22,0,0,0},
 {0,4,8,12,16,16,17,17,18,18,19,19,19,19,20,20,20,20,20,21,21,21,21,21,21,22,22,22,22,22,22,22,22,22,23,23,23,23,23,23,23,23,23,23,23,23,24,24,24,24,24,24,24,24,24,24,24,24,24,24,24,24,25,25,25,25,25,25,25,25,25,25,25,25,25,25,25,25,25,25,25,25,25,26,26,26,26,26,26,26,26,26,26,26,26,26,26,26,26,26,26,26,26,26,26,26,26,26,26,26,26,26,26,27,27,27,27,27,27,27,27,27,27,27,27,27,27,27,27,0,0,0},
 {0,16,18,19,20,21,21,22,22,23,23,23,24,24,24,24,25,25,25,25,25,26,26,26,26,26,26,26,26,27,27,27,27,27,27,27,27,27,27,28,28,28,28,28,28,28,28,28,28,28,28,28,29,29,29,29,29,29,29,29,29,29,29,29,29,29,29,29,29,29,30,30,30,30,30,30,30,30,30,30,30,30,30,30,30,30,30,30,30,30,30,30,30,30,30,31,31,31,31,31,31,31,31,31,31,31,31,31,31,31,31,31,31,31,31,31,31,31,31,31,31,31,31,31,31,31,31,31,31,0,0,0}};
#define GAS __attribute__((address_space(1)))
#define LAS __attribute__((address_space(3)))
typedef unsigned short bf16;
typedef unsigned v4u __attribute__((ext_vector_type(4)));
typedef float f32x4 __attribute__((ext_vector_type(4)));
typedef short bf16x8 __attribute__((ext_vector_type(8)));
typedef GAS unsigned gu32;
typedef GAS unsigned long long gu64;
#define RLX_AGENT __ATOMIC_RELAXED, __HIP_MEMORY_SCOPE_AGENT
#define LDS_WAIT() asm volatile("s_waitcnt lgkmcnt(0)" ::: "memory")
#define VM_WAIT() asm volatile("s_waitcnt vmcnt(0)" ::: "memory")
__device__ __forceinline__ unsigned long long rt() { return __builtin_amdgcn_s_memrealtime(); }
__device__ __forceinline__ unsigned f2bf(float f) { unsigned u = __builtin_bit_cast(unsigned, f); return (u + 0x7fffu + ((u >> 16) & 1u)) >> 16; }
__device__ __forceinline__ unsigned pk2(float lo, float hi) { return f2bf(lo) | (f2bf(hi) << 16); }

#define XB_TMO      128
#define XB_XCNT(j)  (256  + 64 * (j))
#define XB_XSUB(j)  (1280 + 64 * (j))
#define XB_XGEN(j)  (2304 + 64 * (j))
#define XB_TOP      3328
#define XB_TOPGEN   3392
#define XCD_BAR_WORDS 3456
#define XB_SPIN_CAP (1u << 23)

__device__ __forceinline__ unsigned xb_ld(unsigned* p)              { return __hip_atomic_load(p, __ATOMIC_RELAXED, __HIP_MEMORY_SCOPE_AGENT); }
__device__ __forceinline__ unsigned xb_add(unsigned* p, unsigned v) { return __hip_atomic_fetch_add(p, v, __ATOMIC_RELAXED, __HIP_MEMORY_SCOPE_AGENT); }
__device__ __forceinline__ unsigned xb_xcc_id() { return (unsigned)__builtin_amdgcn_s_getreg((3 << 11) | 20) & 0xFu; }
#define XB_SPIN(cond, bar) do { unsigned _sp = 0; while (cond) { __builtin_amdgcn_s_sleep(1); \
    if ((++_sp & 255u) == 0u) { if (xb_ld(&(bar)[XB_TMO])) break; if (_sp > XB_SPIN_CAP) { atomicAdd(&(bar)[XB_TMO], 1u); break; } } } } while (0)

struct XcdBarrier {
    unsigned* bar; unsigned x;
    volatile LAS unsigned* st;
};

__device__ __forceinline__ XcdBarrier xcd_barrier_post(unsigned* bar, volatile LAS unsigned* st) {
    XcdBarrier b; b.bar = bar; b.x = xb_xcc_id(); b.st = st;
    if (threadIdx.x == 0) (void)xb_add(&bar[XB_XCNT(b.x)], 1u);
    return b;
}
__device__ __forceinline__ void xcd_barrier_complete(unsigned* bar, unsigned x, unsigned& nloc, unsigned& nx) {
    const unsigned G = gridDim.x * gridDim.y * gridDim.z;
    unsigned sum, cnt, mine, sp = 0u;
    for (;;) {
        sum = 0u; cnt = 0u; mine = 0u;
#pragma unroll
        for (unsigned j = 0; j < 16; ++j) { const unsigned c = xb_ld(&bar[XB_XCNT(j)]); sum += c; cnt += (c > 0u) ? 1u : 0u; mine = (j == x) ? c : mine; }
        if (sum == G) break;
        __builtin_amdgcn_s_sleep(1);
        if ((++sp & 255u) == 0u) { if (xb_ld(&bar[XB_TMO])) break; if (sp > XB_SPIN_CAP) { atomicAdd(&bar[XB_TMO], 1u); break; } }
    }
    nloc = mine > 0u ? mine : 1u; nx = cnt > 0u ? cnt : 1u;
}

__device__ __forceinline__ void xcd_barrier(const XcdBarrier& b) {
    asm volatile("s_waitcnt vmcnt(0)" ::: "memory");
    __syncthreads();
    if (threadIdx.x == 0) {
        unsigned* bar = b.bar;
        __builtin_amdgcn_s_waitcnt(0);
        unsigned nloc = b.st[0], nx = b.st[1];
        if (nloc == 0u) { xcd_barrier_complete(bar, b.x, nloc, nx); b.st[0] = nloc; b.st[1] = nx; }
        const unsigned old = xb_add(&bar[XB_XSUB(b.x)], 1u);
        const unsigned gen = old / nloc;
        if (old + 1u == (gen + 1u) * nloc) {
            __builtin_amdgcn_fence(__ATOMIC_RELEASE, "agent");
            asm volatile("s_waitcnt vmcnt(0)" ::: "memory");
            const unsigned og = xb_add(&bar[XB_TOP], 1u);
            const unsigned tg = og / nx;
            if (og + 1u == (tg + 1u) * nx) xb_add(&bar[XB_TOPGEN], 1u);
            else XB_SPIN(xb_ld(&bar[XB_TOPGEN]) == tg, bar);
            __builtin_amdgcn_fence(__ATOMIC_ACQUIRE, "agent");
            xb_add(&bar[XB_XGEN(b.x)], 1u);
            asm volatile("s_waitcnt vmcnt(0)" ::: "memory");
        } else {
            XB_SPIN(xb_ld(&bar[XB_XGEN(b.x)]) == gen, bar);
            __builtin_amdgcn_fence(__ATOMIC_ACQUIRE, "agent");
            asm volatile("s_waitcnt vmcnt(0)" ::: "memory");
        }
    }
    __syncthreads();
}
struct Args { const float* in[22]; float* out; unsigned char* ws; int ph_lo, ph_hi, li, pad; };
enum { I_X = 0, I_C, I_ADAW, I_ADAB, I_LNG, I_LNB, I_ABWIN, I_WAUP, I_BA, I_GLAG, I_CONVW, I_CONVB, I_BI, I_BF, I_MLG, I_ABWOUT, I_CDWIN, I_RELB, I_CDWOUT, I_W1, I_W3, I_W2 };
struct Frame {
    LAS unsigned char* lds; volatile LAS unsigned* MISC; gu32* ctl;
    int tid, lane, wave, vcu, G;
};
__device__ __forceinline__ float wave_sum(float v) {
#pragma unroll
    for (int o = 1; o < 64; o <<= 1) v += __shfl_xor(v, o);
    return v;
}
__device__ __forceinline__ float bf2f(unsigned short h) { return __uint_as_float((unsigned)h << 16); }
__device__ __forceinline__ float bflo(unsigned w) { return __uint_as_float(w << 16); }
__device__ __forceinline__ float bfhi(unsigned w) { return __uint_as_float(w & 0xffff0000u); }
__device__ __forceinline__ float sigmoid_f(float x) { return __builtin_amdgcn_rcpf(1.0f + __expf(-x)); }
__device__ __forceinline__ float silu2(float x) { return x * sigmoid_f(x); }
__device__ __forceinline__ float logsig_f(float x) { return fminf(x, 0.f) - log1pf(__expf(-fabsf(x))); }
__device__ __forceinline__ float softplus_f(float x) { return fmaxf(x, 0.f) + log1pf(__expf(-fabsf(x))); }

__device__ __forceinline__ void tr_item(const float* W, int ldw, int src_col0, int k0, bf16* WT, int ldt, int dst_row0, LAS float* scr, int lane) {
#pragma unroll 8
    for (int i = 0; i < 32; ++i) { const int kk = 2 * i + (lane >> 5); scr[kk * 33 + (lane & 31)] = W[(size_t)(k0 + kk) * ldw + src_col0 + (lane & 31)]; }
    LDS_WAIT(); asm volatile("" ::: "memory");
    const int c = lane & 7;
#pragma unroll
    for (int j = 0; j < 4; ++j) { const int n = (lane >> 3) + 8 * j; const LAS float* s = scr + (8 * c) * 33 + n;
        v4u o; o.x = pk2(s[0 * 33], s[1 * 33]); o.y = pk2(s[2 * 33], s[3 * 33]); o.z = pk2(s[4 * 33], s[5 * 33]); o.w = pk2(s[6 * 33], s[7 * 33]);
        *(GAS v4u*)(WT + (size_t)(dst_row0 + n) * ldt + k0 + 8 * c) = o; }
    LDS_WAIT(); asm volatile("" ::: "memory");
}
__device__ __forceinline__ void phase_prologue(const Frame& F, const Args& A) {
    unsigned char* ws = A.ws;
    if (F.vcu < 192) {
        LAS float* cact = (LAS float*)(F.lds);
        LAS float* red = (LAS float*)(F.lds + 32768);
        for (int e = F.tid; e < 8192; e += 512) cact[e] = silu2(A.in[I_C][e]);
        __syncthreads();
        for (int it = F.vcu; it < 192; it += F.G) {
            const int l = it / 96, cb = it % 96, col = cb * 64 + F.lane;
            const float* w = A.in[I_ADAW] + (size_t)l * 1024 * 6144 + col;
            float acc[8];
#pragma unroll
            for (int b = 0; b < 8; ++b) acc[b] = 0.f;
            const int kb = F.wave * 128;
#pragma unroll 8
            for (int k = 0; k < 128; ++k) { const float wv = w[(size_t)(kb + k) * 6144];
#pragma unroll
                for (int b = 0; b < 8; ++b) acc[b] += cact[b * 1024 + kb + k] * wv; }
#pragma unroll
            for (int b = 0; b < 8; ++b) red[(F.wave * 8 + b) * 64 + F.lane] = acc[b];
            __syncthreads();
            { const int b = F.wave; float s = A.in[I_ADAB][l * 6144 + col];
#pragma unroll
              for (int w8 = 0; w8 < 8; ++w8) s += red[(w8 * 8 + b) * 64 + F.lane];
              ((float*)(ws + WS_MOD))[(size_t)(l * 8 + b) * 6144 + col] = s; }
            __syncthreads();
        }
    }
    __syncthreads();
    LAS float* scr = (LAS float*)(F.lds + F.wave * 16384);
    const int gw = F.vcu * NWAVES + F.wave, NGW = F.G * NWAVES;
    constexpr int I_A = 112 * 16, I_B = 32 * 16, I_C2 = 120 * 16, I_D = 32 * 12, I_E = 176 * 16 * 2, I_F = 32 * 44 * 2;
    constexpr int NITEMS = I_A + I_B + I_C2 + I_D + I_E + I_F;
    for (int it = gw; it < NITEMS; it += NGW) {
        int r = it;
        if (r < I_A) { const int nb = r / 16, kb = r % 16, d0 = 32 * nb; const int s0 = d0 < 1536 ? d0 : (d0 < 2560 ? 1552 + (d0 - 1536) : (d0 < 3072 ? 2576 + (d0 - 2560) : 3096 + (d0 - 3072)));
            tr_item(A.in[I_ABWIN], AB_IN, s0, 64 * kb, (bf16*)(ws + WS_WAB), 1024, d0, scr, F.lane); continue; } r -= I_A;
        if (r < I_B) { const int nb = r / 16, kb = r % 16; tr_item(A.in[I_ABWOUT], 1024, 32 * nb, 64 * kb, (bf16*)(ws + WS_WABO), 1024, 32 * nb, scr, F.lane); continue; } r -= I_B;
        if (r < I_C2) { const int nb = r / 16, kb = r % 16; tr_item(A.in[I_CDWIN], NCD, 32 * nb, 64 * kb, (bf16*)(ws + WS_WCD), 1024, 32 * nb, scr, F.lane); continue; } r -= I_C2;
        if (r < I_D) { const int nb = r / 12, kb = r % 12; tr_item(A.in[I_CDWOUT], 1024, 32 * nb, 64 * kb, (bf16*)(ws + WS_WCDO), CDO, 32 * nb, scr, F.lane); continue; } r -= I_D;
        if (r < I_E) { const int l = r / (176 * 16), q = r % (176 * 16), nb = q / 16, kb = q % 16, d0 = 32 * nb, pn = d0 >> 8, rr = d0 & 255, bj = rr >> 7, ff0 = 128 * pn + (rr & 127);
            tr_item((bj ? A.in[I_W3] : A.in[I_W1]) + (size_t)l * 1024 * FF, FF, ff0, 64 * kb, (bf16*)(ws + WS_W13) + (size_t)l * NFF2 * 1024, 1024, d0, scr, F.lane); continue; } r -= I_E;
        { const int l = r / (32 * 44), q = r % (32 * 44), nb = q / 44, kb = q % 44;
            tr_item(A.in[I_W2] + (size_t)l * FF * 1024, 1024, 32 * nb, 64 * kb, (bf16*)(ws + WS_W2) + (size_t)l * 1024 * FF, FF, 32 * nb, scr, F.lane); }
    }
}
__device__ __forceinline__ void phase_xn0(const Frame& F, const Args& A) {
    unsigned char* ws = A.ws;
    LAS float* W24 = (LAS float*)F.lds;
    for (int e = F.tid; e < 32 * 1024; e += 512) { const int g = e & 31, k = e >> 5; if (g < 24) { const int sc = g < 16 ? 1536 + g : 3088 + (g - 16); W24[g * 1024 + k] = A.in[I_ABWIN][(size_t)k * AB_IN + sc]; } }
    __syncthreads();
    const float* mod = (const float*)(ws + WS_MOD);
    const int gw = F.vcu * NWAVES + F.wave, NGW = F.G * NWAVES;
    for (int m = gw; m < T; m += NGW) {
        const int b = m >> 12;
        const GAS f32x4* xr = (const GAS f32x4*)(A.in[I_X] + (size_t)m * D) + F.lane;
        const f32x4* scp = (const f32x4*)(mod + (size_t)b * 6144 + MO_SCM) + F.lane; const f32x4* shp = (const f32x4*)(mod + (size_t)b * 6144 + MO_SHM) + F.lane;
        f32x4 v[4];
#pragma unroll
        for (int j = 0; j < 4; ++j) v[j] = xr[64 * j] * (scp[64 * j] + 1.0f) + shp[64 * j];
        GAS unsigned long long* o8 = (GAS unsigned long long*)((bf16*)(ws + WS_XN) + (size_t)m * D) + F.lane;
#pragma unroll
        for (int j = 0; j < 4; ++j) o8[64 * j] = (unsigned long long)pk2(v[j].x, v[j].y) | ((unsigned long long)pk2(v[j].z, v[j].w) << 32);
        float keep = 0.f;
#pragma unroll 4
        for (int g = 0; g < 24; ++g) { float p = 0.f;
#pragma unroll
            for (int j = 0; j < 4; ++j) { const f32x4 w = *(const LAS f32x4*)(W24 + g * 1024 + 256 * j + 4 * F.lane); p += (v[j].x * w.x + v[j].y * w.y) + (v[j].z * w.z + v[j].w * w.w); }
            p = wave_sum(p); if (F.lane == g) keep = p; }
        if (F.lane < 24) ((float*)(ws + WS_G24))[(size_t)m * 24 + F.lane] = keep;
    }
}
template <bool FINAL> __device__ __forceinline__ void phase_ln(const Frame& F, const Args& A, int lnidx, int modl, int mo_sc, int mo_sh) {
    unsigned char* ws = A.ws;
    const float* mod = (const float*)(ws + WS_MOD) + (size_t)modl * 8 * 6144;
    const f32x4* gp = (const f32x4*)(A.in[I_LNG] + lnidx * 1024) + F.lane; const f32x4* bp = (const f32x4*)(A.in[I_LNB] + lnidx * 1024) + F.lane;
    const int gw = F.vcu * NWAVES + F.wave, NGW = F.G * NWAVES;
    for (int m = gw; m < T; m += NGW) {
        const int b = m >> 12;
        GAS f32x4* ur = (GAS f32x4*)(A.out + (size_t)m * D) + F.lane;
        f32x4 v[4]; float s = 0.f;
#pragma unroll
        for (int j = 0; j < 4; ++j) { v[j] = ur[64 * j]; s += (v[j].x + v[j].y) + (v[j].z + v[j].w); }
        const float mean = wave_sum(s) * (1.f / D); float s2 = 0.f;
#pragma unroll
        for (int j = 0; j < 4; ++j) { v[j] = v[j] - mean; s2 += (v[j].x * v[j].x + v[j].y * v[j].y) + (v[j].z * v[j].z + v[j].w * v[j].w); }
        const float rstd = 1.f / sqrtf(wave_sum(s2) * (1.f / D) + LN_EPS);
        if (FINAL) {
#pragma unroll
            for (int j = 0; j < 4; ++j) ur[64 * j] = v[j] * rstd * gp[64 * j] + bp[64 * j];
        } else {
            if (F.lane == 0) { float* st = (float*)(ws + WS_STATS) + 2 * (size_t)m; st[0] = mean; st[1] = rstd; }
            const f32x4* scp = (const f32x4*)(mod + (size_t)b * 6144 + mo_sc) + F.lane; const f32x4* shp = (const f32x4*)(mod + (size_t)b * 6144 + mo_sh) + F.lane;
            GAS unsigned long long* o8 = (GAS unsigned long long*)((bf16*)(ws + WS_XN) + (size_t)m * D) + F.lane;
#pragma unroll
            for (int j = 0; j < 4; ++j) { const f32x4 y = (v[j] * rstd * gp[64 * j] + bp[64 * j]) * (scp[64 * j] + 1.0f) + shp[64 * j];
                o8[64 * j] = (unsigned long long)pk2(y.x, y.y) | ((unsigned long long)pk2(y.z, y.w) << 32); }
        }
    }
}
__device__ __forceinline__ void phase_mix0_pre(const Frame& F, const Args& A) {
    unsigned char* ws = A.ws;
    const bf16* P0 = (const bf16*)(ws + WS_BIG); bf16* QKc = (bf16*)(ws + WS_XN); float* ADEC = (float*)(ws + WS_ADEC); const float* G24 = (const float*)(ws + WS_G24);
    const float* cw = A.in[I_CONVW]; const float* cb = A.in[I_CONVB];
    const int gw = F.vcu * NWAVES + F.wave, NGW = F.G * NWAVES;
    for (int m = gw; m < T; m += NGW) {
        const int t = m & (SEQ - 1);
#pragma unroll
        for (int jj = 0; jj < 4; ++jj) { const int c0 = 256 * jj + 4 * F.lane;
            f32x4 acc = *(const f32x4*)(cb + c0);
#pragma unroll
            for (int j = 0; j < 4; ++j) { const int dt = 3 - j; if (t - dt >= 0) { const uint2 raw = *(const uint2*)(P0 + (size_t)(m - dt) * NAB + C_QKB + c0); const f32x4 w = *(const f32x4*)(cw + j * 1024 + c0);
                    acc.x += bflo(raw.x) * w.x; acc.y += bfhi(raw.x) * w.y; acc.z += bflo(raw.y) * w.z; acc.w += bfhi(raw.y) * w.w; } }
            const float ksc = (c0 >= 512) ? 0.08838834764831845f : 1.0f;
            acc.x = silu2(acc.x) * ksc; acc.y = silu2(acc.y) * ksc; acc.z = silu2(acc.z) * ksc; acc.w = silu2(acc.w) * ksc;
            *(uint2*)(QKc + (size_t)m * 1024 + c0) = make_uint2(pk2(acc.x, acc.y), pk2(acc.z, acc.w)); }
        { const int c0 = 4 * F.lane; f32x4 pre = *(const f32x4*)(A.in[I_BA] + c0);
#pragma unroll
          for (int r = 0; r < 16; ++r) { const float a = G24[(size_t)m * 24 + r]; pre += *(const f32x4*)(A.in[I_WAUP] + r * 256 + c0) * a; }
          f32x4 o; o.x = __expf(logsig_f(pre.x) * 0.0625f); o.y = __expf(logsig_f(pre.y) * 0.0625f); o.z = __expf(logsig_f(pre.z) * 0.0625f); o.w = __expf(logsig_f(pre.w) * 0.0625f);
          *(f32x4*)(ADEC + (size_t)m * 256 + c0) = o; }
    }
}
__device__ __forceinline__ void phase_mix0_rec(const Frame& F, const Args& A) {
    if (F.wave != 0 || F.vcu >= 160) return;
    unsigned char* ws = A.ws;
    const bf16* P0 = (const bf16*)(ws + WS_BIG); const bf16* QKc = (const bf16*)(ws + WS_XN); const float* ADEC = (const float*)(ws + WS_ADEC); const float* G24 = (const float*)(ws + WS_G24);
    float* RAW = A.out; const int lane = F.lane;
    LAS float* L = (LAS float*)F.lds;
    if (F.vcu < 64) {
        const int it = F.vcu, b = it >> 3, h = (it >> 1) & 3, half = it & 1, dv = half * 64 + lane; const size_t r0 = (size_t)b * SEQ;
        LAS float* La = L; LAS float* Lk = L + 1024; LAS float* Lq = L + 2048; LAS float* Lv = L + 3072;
        float S[64];
#pragma unroll
        for (int i = 0; i < 64; ++i) S[i] = 0.f;
        for (int t0 = 0; t0 < SEQ; t0 += 16) {
            { const int st = lane >> 2, sg = lane & 3; const size_t row = r0 + t0 + st;
#pragma unroll
              for (int i = 0; i < 4; ++i) *(LAS f32x4*)(La + st * 64 + sg * 16 + 4 * i) = *(const f32x4*)(ADEC + row * 256 + h * 64 + sg * 16 + 4 * i);
#pragma unroll
              for (int i = 0; i < 2; ++i) { const v4u kk = *(const v4u*)(P0 + row * NAB + C_KA + h * 64 + sg * 16 + 8 * i), qq = *(const v4u*)(P0 + row * NAB + C_QA + h * 64 + sg * 16 + 8 * i);
                  LAS float* pk = Lk + st * 64 + sg * 16 + 8 * i; LAS float* pq = Lq + st * 64 + sg * 16 + 8 * i;
                  pk[0] = bflo(kk.x); pk[1] = bfhi(kk.x); pk[2] = bflo(kk.y); pk[3] = bfhi(kk.y); pk[4] = bflo(kk.z); pk[5] = bfhi(kk.z); pk[6] = bflo(kk.w); pk[7] = bfhi(kk.w);
                  pq[0] = bflo(qq.x); pq[1] = bfhi(qq.x); pq[2] = bflo(qq.y); pq[3] = bfhi(qq.y); pq[4] = bflo(qq.z); pq[5] = bfhi(qq.z); pq[6] = bflo(qq.w); pq[7] = bfhi(qq.w); }
#pragma unroll
              for (int s = 0; s < 16; ++s) Lv[s * 64 + lane] = bf2f(P0[(r0 + t0 + s) * NAB + C_VA + h * 128 + dv]); }
            LDS_WAIT(); asm volatile("" ::: "memory");
#pragma unroll 1
            for (int s = 0; s < 16; ++s) { const float vv = Lv[s * 64 + lane]; float o = 0.f;
#pragma unroll
                for (int k4 = 0; k4 < 16; ++k4) { const f32x4 a = *(const LAS f32x4*)(La + s * 64 + 4 * k4), kk = *(const LAS f32x4*)(Lk + s * 64 + 4 * k4), qq = *(const LAS f32x4*)(Lq + s * 64 + 4 * k4);
                    S[4 * k4 + 0] = a.x * S[4 * k4 + 0] + kk.x * vv; o += qq.x * S[4 * k4 + 0];
                    S[4 * k4 + 1] = a.y * S[4 * k4 + 1] + kk.y * vv; o += qq.y * S[4 * k4 + 1];
                    S[4 * k4 + 2] = a.z * S[4 * k4 + 2] + kk.z * vv; o += qq.z * S[4 * k4 + 2];
                    S[4 * k4 + 3] = a.w * S[4 * k4 + 3] + kk.w * vv; o += qq.w * S[4 * k4 + 3]; }
                RAW[(r0 + t0 + s) * 1024 + h * 128 + dv] = o; }
            LDS_WAIT(); asm volatile("" ::: "memory");
        }
    } else if (F.vcu < 128) {
        const int it = F.vcu - 64, b = it >> 3, h = (it >> 1) & 3, vh = it & 1, vi = vh * 64 + lane; const size_t r0 = (size_t)b * SEQ;
        LAS float* Lk = L; LAS float* Lq = L + 1024; LAS float* Lv = L + 2048; LAS float* Lf = L + 2560;
        const float bi = A.in[I_BI][h], bfv = A.in[I_BF][h];
        float C[128];
#pragma unroll
        for (int i = 0; i < 128; ++i) C[i] = 0.f;
        for (int t0 = 0; t0 < SEQ; t0 += 8) {
            { const int st = lane >> 3, sg = lane & 7; const size_t row = r0 + t0 + st;
#pragma unroll
              for (int i = 0; i < 2; ++i) { const v4u qq = *(const v4u*)(QKc + row * 1024 + h * 128 + sg * 16 + 8 * i), kk = *(const v4u*)(QKc + row * 1024 + 512 + h * 128 + sg * 16 + 8 * i);
                  LAS float* pk = Lk + st * 128 + sg * 16 + 8 * i; LAS float* pq = Lq + st * 128 + sg * 16 + 8 * i;
                  pk[0] = bflo(kk.x); pk[1] = bfhi(kk.x); pk[2] = bflo(kk.y); pk[3] = bfhi(kk.y); pk[4] = bflo(kk.z); pk[5] = bfhi(kk.z); pk[6] = bflo(kk.w); pk[7] = bfhi(kk.w);
                  pq[0] = bflo(qq.x); pq[1] = bfhi(qq.x); pq[2] = bflo(qq.y); pq[3] = bfhi(qq.y); pq[4] = bflo(qq.z); pq[5] = bfhi(qq.z); pq[6] = bflo(qq.w); pq[7] = bfhi(qq.w); }
#pragma unroll
              for (int s = 0; s < 8; ++s) Lv[s * 64 + lane] = bf2f(P0[(r0 + t0 + s) * NAB + C_VB + h * 128 + vi]);
              if (lane < 8) { const size_t rw = r0 + t0 + lane; Lf[2 * lane] = sigmoid_f(G24[rw * 24 + 20 + h] + bfv); Lf[2 * lane + 1] = __expf(G24[rw * 24 + 16 + h] + bi); } }
            LDS_WAIT(); asm volatile("" ::: "memory");
#pragma unroll 1
            for (int s = 0; s < 8; ++s) { const float f = Lf[2 * s], iv = Lf[2 * s + 1] * Lv[s * 64 + lane]; float num = 0.f;
#pragma unroll
                for (int k4 = 0; k4 < 32; ++k4) { const f32x4 kk = *(const LAS f32x4*)(Lk + s * 128 + 4 * k4), qq = *(const LAS f32x4*)(Lq + s * 128 + 4 * k4);
                    C[4 * k4 + 0] = f * C[4 * k4 + 0] + iv * kk.x; num += C[4 * k4 + 0] * qq.x;
                    C[4 * k4 + 1] = f * C[4 * k4 + 1] + iv * kk.y; num += C[4 * k4 + 1] * qq.y;
                    C[4 * k4 + 2] = f * C[4 * k4 + 2] + iv * kk.z; num += C[4 * k4 + 2] * qq.z;
                    C[4 * k4 + 3] = f * C[4 * k4 + 3] + iv * kk.w; num += C[4 * k4 + 3] * qq.w; }
                RAW[(r0 + t0 + s) * 1024 + 512 + h * 128 + vi] = num; }
            LDS_WAIT(); asm volatile("" ::: "memory");
        }
    } else {
        const int it = F.vcu - 128, b = it >> 2, h = it & 3; const size_t r0 = (size_t)b * SEQ;
        const float bi = A.in[I_BI][h], bfv = A.in[I_BF][h]; float* DEN = (float*)(ws + WS_DEN);
        float n0 = 0.f, n1 = 0.f;
        for (int t0 = 0; t0 < SEQ; t0 += 8) {
            float k0[8], k1[8], q0[8], q1[8], ff[8], ii[8];
#pragma unroll
            for (int s = 0; s < 8; ++s) { const size_t row = r0 + t0 + s; q0[s] = bf2f(QKc[row * 1024 + h * 128 + lane]); q1[s] = bf2f(QKc[row * 1024 + h * 128 + 64 + lane]);
                k0[s] = bf2f(QKc[row * 1024 + 512 + h * 128 + lane]); k1[s] = bf2f(QKc[row * 1024 + 512 + h * 128 + 64 + lane]);
                ff[s] = sigmoid_f(G24[row * 24 + 20 + h] + bfv); ii[s] = __expf(G24[row * 24 + 16 + h] + bi); }
#pragma unroll
            for (int s = 0; s < 8; ++s) { n0 = ff[s] * n0 + ii[s] * k0[s]; n1 = ff[s] * n1 + ii[s] * k1[s]; const float d = wave_sum(n0 * q0[s] + n1 * q1[s]); if (lane == 0) DEN[(r0 + t0 + s) * 4 + h] = d; }
        }
    }
}
__device__ __forceinline__ void phase_mix0_post(const Frame& F, const Args& A) {
    unsigned char* ws = A.ws;
    const bf16* P0 = (const bf16*)(ws + WS_BIG); const float* RAW = A.out; const float* DEN = (const float*)(ws + WS_DEN); bf16* MIX = (bf16*)(ws + WS_MIX);
    const int gw = F.vcu * NWAVES + F.wave, NGW = F.G * NWAVES, lane = F.lane;
    for (int m = gw; m < T; m += NGW) {
#pragma unroll
        for (int hh = 0; hh < 8; ++hh) { const int h = hh & 3, ml = hh >> 2, c0 = ml * 512 + h * 128 + 2 * lane;
            float2 x = *(const float2*)(RAW + (size_t)m * 1024 + c0);
            if (ml) { const float dd = fmaxf(fabsf(DEN[(size_t)m * 4 + h]), 1.0f); x.x /= dd; x.y /= dd; }
            const float mean = wave_sum(x.x + x.y) * (1.f / 128.f); x.x -= mean; x.y -= mean;
            const float rstd = 1.f / sqrtf(wave_sum(x.x * x.x + x.y * x.y) * (1.f / 128.f) + LN_EPS);
            const float2 g = *(const float2*)((ml ? A.in[I_MLG] : A.in[I_GLAG]) + h * 128 + 2 * lane);
            const unsigned gr = *(const unsigned*)(P0 + (size_t)m * NAB + (ml ? C_OB : C_RA) + h * 128 + 2 * lane); const float g0 = bflo(gr), g1 = bfhi(gr);
            const float y0 = x.x * rstd * g.x * (ml ? sigmoid_f(g0) : silu2(g0)), y1 = x.y * rstd * g.y * (ml ? sigmoid_f(g1) : silu2(g1));
            *(unsigned*)(MIX + (size_t)m * 1024 + c0) = pk2(y0, y1); }
    }
}
__device__ __forceinline__ void phase_mix1_sb(const Frame& F, const Args& A) {
    unsigned char* ws = A.ws;
    const bf16* P1 = (const bf16*)(ws + WS_BIG); bf16* MIX = (bf16*)(ws + WS_MIX);
    const int gw = F.vcu * NWAVES + F.wave, NGW = F.G * NWAVES, lane = F.lane;
    LAS unsigned* LK = (LAS unsigned*)(F.lds + F.wave * 16384); LAS unsigned* LV = LK + 2048;
    for (int it0 = gw; it0 < 2048; it0 += NGW)
    for (int pass = 0; pass < 2; ++pass) {
        const int it = pass ? 4095 - it0 : it0; const int bh = it & 63, qblk = it >> 6, b = bh >> 3, h = bh & 7;
        const size_t r0 = (size_t)b * SEQ; const int t = qblk * 64 + lane;
        float q[64], o[64];
#pragma unroll
        for (int i = 0; i < 8; ++i) { const v4u w = *(const v4u*)(P1 + (r0 + t) * NCD + C_QC + h * 64 + 8 * i);
            q[8 * i] = bflo(w.x); q[8 * i + 1] = bfhi(w.x); q[8 * i + 2] = bflo(w.y); q[8 * i + 3] = bfhi(w.y); q[8 * i + 4] = bflo(w.z); q[8 * i + 5] = bfhi(w.z); q[8 * i + 6] = bflo(w.w); q[8 * i + 7] = bfhi(w.w); }
#pragma unroll
        for (int i = 0; i < 64; ++i) o[i] = 0.f;
        float accs = 0.f;
        for (int kt = qblk; kt >= 0; --kt) {
#pragma unroll
            for (int i = 0; i < 8; ++i) { *(LAS v4u*)(LK + lane * 32 + 4 * i) = *(const v4u*)(P1 + (r0 + kt * 64 + lane) * NCD + C_KC + h * 64 + 8 * i);
                                          *(LAS v4u*)(LV + lane * 32 + 4 * i) = *(const v4u*)(P1 + (r0 + kt * 64 + lane) * NCD + C_VC + h * 64 + 8 * i); }
            LDS_WAIT(); asm volatile("" ::: "memory");
#pragma unroll 1
            for (int sl = 63; sl >= 0; --sl) { const int s = kt * 64 + sl; float z = 0.f;
#pragma unroll
                for (int i = 0; i < 8; ++i) { const v4u w = *(const LAS v4u*)(LK + sl * 32 + 4 * i);
                    z += q[8 * i] * bflo(w.x) + q[8 * i + 1] * bfhi(w.x) + q[8 * i + 2] * bflo(w.y) + q[8 * i + 3] * bfhi(w.y) + q[8 * i + 4] * bflo(w.z) + q[8 * i + 5] * bfhi(w.z) + q[8 * i + 6] * bflo(w.w) + q[8 * i + 7] * bfhi(w.w); }
                float p = 0.f;
                if (s < t) { accs += softplus_f(z); p = __expf(z - accs); }
#pragma unroll
                for (int i = 0; i < 8; ++i) { const v4u w = *(const LAS v4u*)(LV + sl * 32 + 4 * i);
                    o[8 * i] += p * bflo(w.x); o[8 * i + 1] += p * bfhi(w.x); o[8 * i + 2] += p * bflo(w.y); o[8 * i + 3] += p * bfhi(w.y); o[8 * i + 4] += p * bflo(w.z); o[8 * i + 5] += p * bfhi(w.z); o[8 * i + 6] += p * bflo(w.w); o[8 * i + 7] += p * bfhi(w.w); } }
            LDS_WAIT(); asm volatile("" ::: "memory");
        }
#pragma unroll
        for (int i = 0; i < 8; ++i) { v4u w; w.x = pk2(o[8 * i], o[8 * i + 1]); w.y = pk2(o[8 * i + 2], o[8 * i + 3]); w.z = pk2(o[8 * i + 4], o[8 * i + 5]); w.w = pk2(o[8 * i + 6], o[8 * i + 7]);
            *(v4u*)(MIX + (r0 + t) * CDO + h * 64 + 8 * i) = w; }
    }
}
__device__ __forceinline__ void phase_mix1_dil(const Frame& F, const Args& A) {
    unsigned char* ws = A.ws;
    const bf16* P1 = (const bf16*)(ws + WS_BIG); bf16* MIX = (bf16*)(ws + WS_MIX); const float* relb = A.in[I_RELB];
    for (int gi = F.vcu * 512 + F.tid; gi < BATCH * 4 * SEQ; gi += F.G * 512) {
        const int t = gi & (SEQ - 1), hg = (gi >> 12) & 3, b = gi >> 14; const size_t r0 = (size_t)b * SEQ;
        float o[64]; float mx = -1e30f, l = 0.f;
#pragma unroll
        for (int i = 0; i < 64; ++i) o[i] = 0.f;
#pragma unroll 1
        for (int g = 0; g < 3; ++g) { const int dil = g == 0 ? 1 : (g == 1 ? 4 : 16), hd = g * 4 + hg;
            float q[64];
#pragma unroll
            for (int i = 0; i < 8; ++i) { const v4u w = *(const v4u*)(P1 + (r0 + t) * NCD + C_QD + hd * 64 + 8 * i);
                q[8 * i] = bflo(w.x); q[8 * i + 1] = bfhi(w.x); q[8 * i + 2] = bflo(w.y); q[8 * i + 3] = bfhi(w.y); q[8 * i + 4] = bflo(w.z); q[8 * i + 5] = bfhi(w.z); q[8 * i + 6] = bflo(w.w); q[8 * i + 7] = bfhi(w.w); }
#pragma unroll 1
            for (int j = 0; j <= 128; ++j) { const int p = t - j * dil; if (p < 0) break;
                float z = relb[BUCKET[g][j] * 12 + hd];
#pragma unroll
                for (int i = 0; i < 8; ++i) { const v4u w = *(const v4u*)(P1 + (r0 + p) * NCD + C_KD + hd * 64 + 8 * i);
                    z += q[8 * i] * bflo(w.x) + q[8 * i + 1] * bfhi(w.x) + q[8 * i + 2] * bflo(w.y) + q[8 * i + 3] * bfhi(w.y) + q[8 * i + 4] * bflo(w.z) + q[8 * i + 5] * bfhi(w.z) + q[8 * i + 6] * bflo(w.w) + q[8 * i + 7] * bfhi(w.w); }
                const float mn = fmaxf(mx, z), al = __expf(mx - mn), pe = __expf(z - mn); mx = mn; l = l * al + pe;
#pragma unroll
                for (int i = 0; i < 8; ++i) { const v4u w = *(const v4u*)(P1 + (r0 + p) * NCD + C_VD + hd * 64 + 8 * i);
                    o[8 * i] = o[8 * i] * al + pe * bflo(w.x); o[8 * i + 1] = o[8 * i + 1] * al + pe * bfhi(w.x); o[8 * i + 2] = o[8 * i + 2] * al + pe * bflo(w.y); o[8 * i + 3] = o[8 * i + 3] * al + pe * bfhi(w.y);
                    o[8 * i + 4] = o[8 * i + 4] * al + pe * bflo(w.z); o[8 * i + 5] = o[8 * i + 5] * al + pe * bfhi(w.z); o[8 * i + 6] = o[8 * i + 6] * al + pe * bflo(w.w); o[8 * i + 7] = o[8 * i + 7] * al + pe * bfhi(w.w); } }
        }
        const float il = 1.0f / l;
#pragma unroll
        for (int i = 0; i < 8; ++i) { v4u w; w.x = pk2(o[8 * i] * il, o[8 * i + 1] * il); w.y = pk2(o[8 * i + 2] * il, o[8 * i + 3] * il); w.z = pk2(o[8 * i + 4] * il, o[8 * i + 5] * il); w.w = pk2(o[8 * i + 6] * il, o[8 * i + 7] * il);
            *(v4u*)(MIX + (r0 + t) * CDO + 512 + hg * 64 + 8 * i) = w; }
    }
}

__global__ void __launch_bounds__(NWAVES * 64, 2) fwd_kernel(Args args) {
    extern __shared__ __attribute__((aligned(16))) unsigned char lds[];
    Frame F;
    F.lds = (LAS unsigned char*)lds;
    F.MISC = (volatile LAS unsigned*)(F.lds + MISC_OFF);
    F.tid = threadIdx.x; F.lane = F.tid & 63; F.wave = __builtin_amdgcn_readfirstlane(F.tid >> 6);
    F.G = gridDim.x; { const int bx = blockIdx.x; F.vcu = (F.G % 8 == 0) ? (bx % 8) * (F.G / 8) + bx / 8 : bx; }
    unsigned char* ws = args.ws;
    F.ctl = (gu32*)(ws + WS_CTL);
    for (int u = F.tid; u < (LDS_BYTES - LDSCTL_OFF) / 4; u += NWAVES * 64) ((LAS unsigned*)(F.lds + LDSCTL_OFF))[u] = 0u;
    __syncthreads();
    XcdBarrier bar; bar.bar = (unsigned*)(F.ctl + CW_BAR); bar.x = 0; bar.st = nullptr;
    if (N_LAUNCHES == 1) bar = xcd_barrier_post((unsigned*)(F.ctl + CW_BAR), F.MISC + 8);
    const int lo = args.ph_lo, hi = args.ph_hi;
#define IN(k) (lo <= (k) && (k) < hi)
#define SEAM(k) do { if (IN(k) && IN((k) + 1)) xcd_barrier(bar); } while (0)
    bf16* XN = (bf16*)(ws + WS_XN); bf16* MIX = (bf16*)(ws + WS_MIX); bf16* BIG = (bf16*)(ws + WS_BIG);
    const float* MOD = (const float*)(ws + WS_MOD); const float* STATS = (const float*)(ws + WS_STATS);
    const float* LNG = args.in[I_LNG]; const float* LNB = args.in[I_LNB];
    if (IN(0)) { phase_prologue(F, args); } SEAM(0);
    if (IN(1)) { phase_xn0(F, args); } SEAM(1);
    if (IN(2)) { pg8::Gemm g{XN, (const bf16*)(ws + WS_WAB), T, NAB, D}; pg8::StaticOrder S; S.init(T, NAB, F.G, (int)blockIdx.x);
        pg8::EpiBf16S E{BIG, NAB, 0x1u};
        pg8::gemm_phase<pg8::EpiBf16S, pg8::StaticOrder, true, true>(F.lds + RING_OFF, g, S, E); } SEAM(2);
    if (IN(3)) { phase_mix0_pre(F, args); } SEAM(3);
    if (IN(4)) { phase_mix0_rec(F, args); } SEAM(4);
    if (IN(5)) { phase_mix0_post(F, args); } SEAM(5);
    if (IN(6)) { pg8::Gemm g{MIX, (const bf16*)(ws + WS_WABO), T, D, D}; pg8::StaticOrder S; S.init(T, D, F.G, (int)blockIdx.x);
        pg8::EpiRes E{args.in[I_X], args.out, nullptr, nullptr, nullptr, MOD + MO_GM, RES_ALPHA};
        pg8::gemm_phase<pg8::EpiRes, pg8::StaticOrder, true, true>(F.lds + RING_OFF, g, S, E); } SEAM(6);
    if (IN(7)) { phase_ln<false>(F, args, 0, 0, MO_SCF, MO_SHF); } SEAM(7);
    if (IN(8)) { pg8::Gemm g{XN, (const bf16*)(ws + WS_W13), T, NFF2, D}; pg8::StaticOrder S; S.init(T, NFF2, F.G, (int)blockIdx.x);
        pg8::EpiSwiglu E{BIG, FF};
        pg8::gemm_phase<pg8::EpiSwiglu, pg8::StaticOrder, true, true>(F.lds + RING_OFF, g, S, E); } SEAM(8);
    if (IN(9)) { pg8::Gemm g{BIG, (const bf16*)(ws + WS_W2), T, D, FF}; pg8::StaticOrder S; S.init(T, D, F.G, (int)blockIdx.x);
        pg8::EpiRes E{args.out, args.out, STATS, LNG + 0 * 1024, LNB + 0 * 1024, MOD + MO_GF, RES_ALPHA};
        pg8::gemm_phase<pg8::EpiRes, pg8::StaticOrder, true, true>(F.lds + RING_OFF, g, S, E); } SEAM(9);
    if (IN(10)) { phase_ln<false>(F, args, 1, 1, MO_SCM, MO_SHM); } SEAM(10);
    if (IN(11)) { pg8::Gemm g{XN, (const bf16*)(ws + WS_WCD), T, NCD, D}; pg8::StaticOrder S; S.init(T, NCD, F.G, (int)blockIdx.x);
        pg8::EpiBf16S E{BIG, NCD, 0x1C3u};
        pg8::gemm_phase<pg8::EpiBf16S, pg8::StaticOrder, true, true>(F.lds + RING_OFF, g, S, E); } SEAM(11);
    if (IN(12)) { phase_mix1_sb(F, args); phase_mix1_dil(F, args); } SEAM(12);
    if (IN(13)) { pg8::Gemm g{MIX, (const bf16*)(ws + WS_WCDO), T, D, CDO}; pg8::StaticOrder S; S.init(T, D, F.G, (int)blockIdx.x);
        pg8::EpiRes E{args.out, args.out, STATS, LNG + 1 * 1024, LNB + 1 * 1024, MOD + 8 * 6144 + MO_GM, RES_ALPHA};
        pg8::gemm_phase<pg8::EpiRes, pg8::StaticOrder, true, true>(F.lds + RING_OFF, g, S, E); } SEAM(13);
    if (IN(14)) { phase_ln<false>(F, args, 2, 1, MO_SCF, MO_SHF); } SEAM(14);
    if (IN(15)) { pg8::Gemm g{XN, (const bf16*)(ws + WS_W13) + (size_t)NFF2 * 1024, T, NFF2, D}; pg8::StaticOrder S; S.init(T, NFF2, F.G, (int)blockIdx.x);
        pg8::EpiSwiglu E{BIG, FF};
        pg8::gemm_phase<pg8::EpiSwiglu, pg8::StaticOrder, true, true>(F.lds + RING_OFF, g, S, E); } SEAM(15);
    if (IN(16)) { pg8::Gemm g{BIG, (const bf16*)(ws + WS_W2) + (size_t)1024 * FF, T, D, FF}; pg8::StaticOrder S; S.init(T, D, F.G, (int)blockIdx.x);
        pg8::EpiRes E{args.out, args.out, STATS, LNG + 2 * 1024, LNB + 2 * 1024, MOD + 8 * 6144 + MO_GF, RES_ALPHA};
        pg8::gemm_phase<pg8::EpiRes, pg8::StaticOrder, true, true>(F.lds + RING_OFF, g, S, E); } SEAM(16);
    if (IN(17)) { phase_ln<true>(F, args, 3, 0, 0, 0); }
#undef IN
#undef SEAM
}

extern "C" void kernel_launch(void* const* d_in, const int* in_sizes, int n_in, void* d_out, int out_size, void* d_ws, size_t ws_size, hipStream_t stream) {
    static int grid = 0;
    if (grid == 0) {
        if (n_in != 22 || in_sizes[0] != T * D || out_size != T * D || ws_size < WS_END) { fprintf(stderr, "kernel_launch: unexpected shapes (n_in %d, in0 %d, out %d, ws %zu); nothing launched\n", n_in, n_in > 0 ? in_sizes[0] : -1, out_size, ws_size); grid = -1; return; }
        int dev = 0, cus = 0, per_cu = 0;
        if (hipGetDevice(&dev) != hipSuccess || hipDeviceGetAttribute(&cus, hipDeviceAttributeMultiprocessorCount, dev) != hipSuccess) { grid = -1; return; }
        if (hipFuncSetAttribute((const void*)fwd_kernel, hipFuncAttributeMaxDynamicSharedMemorySize, LDS_BYTES) != hipSuccess) { fprintf(stderr, "kernel_launch: hipFuncSetAttribute failed\n"); grid = -1; return; }
        if (hipOccupancyMaxActiveBlocksPerMultiprocessor(&per_cu, (const void*)fwd_kernel, NWAVES * 64, LDS_BYTES) != hipSuccess || per_cu < 1) fprintf(stderr, "kernel_launch: occupancy query reports %d workgroups per CU\n", per_cu);
        (void)hipGetLastError();
        grid = cus;
    }
    if (grid < 0) return;
    if (hipMemsetAsync((char*)d_ws + WS_CTL, 0, CTL_ZERO_BYTES, stream) != hipSuccess) { fprintf(stderr, "kernel_launch: hipMemsetAsync failed\n"); return; }
    Args a{};
    for (int i = 0; i < 22; ++i) a.in[i] = (const float*)d_in[i];
    a.out = (float*)d_out; a.ws = (unsigned char*)d_ws;
    if (N_LAUNCHES == 1) { a.ph_lo = 0; a.ph_hi = NPHASE; a.li = 0; hipLaunchKernelGGL(fwd_kernel, dim3(grid), dim3(NWAVES * 64), LDS_BYTES, stream, a); }
    else for (int li = 0; li < NPHASE; ++li) { a.ph_lo = li; a.ph_hi = li + 1; a.li = li; hipLaunchKernelGGL(fwd_kernel, dim3(grid), dim3(NWAVES * 64), LDS_BYTES, stream, a); }
    const hipError_t le = hipPeekAtLastError();
    if (le != hipSuccess) fprintf(stderr, "kernel_launch: launch failed: %s\n", hipGetErrorName(le));
}
```

```cpp
#include <hip/hip_runtime.h>
#include <cstdio>
#include <cstdint>
#ifndef MK_N_LAUNCHES
#define MK_N_LAUNCHES 1
#endif
#ifndef MIX1_MFMA
#define MIX1_MFMA 3
#endif
#ifndef MIX0_MFMA
#define MIX0_MFMA 1
#endif
namespace pg8 {
#define PG8_LAS __attribute__((address_space(3)))
typedef unsigned short bf16_t;
typedef short bf16x8 __attribute__((ext_vector_type(8)));
typedef float f32x4 __attribute__((ext_vector_type(4)));
typedef unsigned u32x4 __attribute__((ext_vector_type(4)));
constexpr int BM = 256, BK = 64, HALF = 128, HTB = HALF * BK * 2  , STAGE_BYTES = 8 * HTB, NXCD = 8, WGM = 8;

__host__ __device__ __forceinline__ int lds_byte(int r, int c) { const int st = (r >> 4) * 2 + (c >> 5), rr = r & 15, cc = c & 31, ob = rr * 64 + cc * 2; return st * 1024 + (ob ^ (((ob >> 9) & 1) << 5)); }
__host__ __device__ __forceinline__ void stage_rc(int b, int& R, int& C) { const int st = b / 1024, sb = b % 1024, swz = sb ^ (((sb >> 9) & 1) << 5); R = (st >> 1) * 16 + swz / 64; C = (st & 1) * 32 + (swz % 64) / 2; }
__host__ __device__ __forceinline__ int perm32(int rho) { const int n = rho >> 4, i = rho & 15; return 8 * (i >> 2) + 4 * n + (i & 3); }

struct Unit { int pm, pn; };
struct Gemm { const bf16_t* A; const bf16_t* Bt; int M, N, K; };

struct StaticOrder {
    int nM, nN, nwg, G, c;
    __host__ __device__ void init(int M, int N, int G_, int c_) { nM = M / BM; nN = N / BM; nwg = nM * nN; G = G_; c = c_; }
    __host__ __device__ bool next(int i, Unit& u) const {
        const long L = (long)i * G + c; if (L >= nwg) return false;
        int wgid = (int)L; { const int q = nwg / NXCD, r = nwg % NXCD, xcd = wgid % NXCD, off = wgid / NXCD; wgid = (xcd < r ? xcd * (q + 1) : r * (q + 1) + (xcd - r) * q) + off; }
        const int nig = WGM * nN, gid = wgid / nig, fm = gid * WGM, gsz = (nM - fm) < WGM ? (nM - fm) : WGM;
        u.pm = fm + ((wgid % nig) % gsz); u.pn = (wgid % nig) / gsz; return true;
    }
    __device__ __forceinline__ void a_ready(const Unit&) const {}
    __device__ __forceinline__ void done(const Unit&) const {}
};

__device__ __forceinline__ unsigned cvt_pk_bf16(float lo, float hi) { unsigned r; asm volatile("v_cvt_pk_bf16_f32 %0, %1, %2" : "=v"(r) : "v"(lo), "v"(hi)); return r; }
typedef float f32x2 __attribute__((ext_vector_type(2)));
struct EpiBf16S {
    static constexpr bool PERM = true, AFTER_DRAIN = false;
    bf16_t* O; int ldc; unsigned scale_mask;
    __device__ __forceinline__ void operator()(const f32x4 (&acc)[2][2][4][2], const Unit& u, int wr, int wc, int fr, int fq) const {
        const int row0 = u.pm * BM + wr * 64 + fr, col0 = u.pn * BM + wc * 32 + 8 * fq;
        const float sc = ((scale_mask >> u.pn) & 1u) ? 0.125f : 1.0f;
#pragma unroll
        for (int ai = 0; ai < 2; ++ai)
#pragma unroll
            for (int m = 0; m < 4; ++m) { bf16_t* rowp = O + (size_t)(row0 + ai * HALF + m * 16) * ldc + col0;
#pragma unroll
                for (int bj = 0; bj < 2; ++bj) { const f32x4 v0 = acc[ai][bj][m][0] * sc, v1 = acc[ai][bj][m][1] * sc;
                    u32x4 w; w.x = cvt_pk_bf16(v0[0], v0[1]); w.y = cvt_pk_bf16(v0[2], v0[3]); w.z = cvt_pk_bf16(v1[0], v1[1]); w.w = cvt_pk_bf16(v1[2], v1[3]);
                    *(u32x4*)(rowp + bj * HALF) = w; } }
    }
};
__device__ __forceinline__ float silu_f(float x) { return x * __builtin_amdgcn_rcpf(1.0f + __builtin_amdgcn_exp2f(-1.4426950408889634f * x)); }
struct EpiSwiglu {
    static constexpr bool PERM = true, AFTER_DRAIN = false;
    bf16_t* G; int ldg;
    __device__ __forceinline__ void operator()(const f32x4 (&acc)[2][2][4][2], const Unit& u, int wr, int wc, int fr, int fq) const {
        const int row0 = u.pm * BM + wr * 64 + fr, col0 = u.pn * HALF + wc * 32 + 8 * fq;
#pragma unroll
        for (int ai = 0; ai < 2; ++ai)
#pragma unroll
            for (int m = 0; m < 4; ++m) { bf16_t* rowp = G + (size_t)(row0 + ai * HALF + m * 16) * ldg + col0;
                float g[8];
#pragma unroll
                for (int n = 0; n < 2; ++n)
#pragma unroll
                    for (int i = 0; i < 4; ++i) g[4 * n + i] = silu_f(acc[ai][0][m][n][i]) * acc[ai][1][m][n][i];
                u32x4 w; w.x = cvt_pk_bf16(g[0], g[1]); w.y = cvt_pk_bf16(g[2], g[3]); w.z = cvt_pk_bf16(g[4], g[5]); w.w = cvt_pk_bf16(g[6], g[7]);
                *(u32x4*)rowp = w; }
    }
};
struct EpiRes {
    static constexpr bool PERM = false, AFTER_DRAIN = false;
    const float* src; float* U; const float* stats; const float* lng; const float* lnb; const float* gate; float alpha;
    __device__ __forceinline__ void operator()(const f32x4 (&acc)[2][2][4][2], const Unit& u, int wr, int wc, int fr, int fq) const {
        const int cb = u.pn * BM + wc * 32 + 4 * fq;
        const float* gt = gate + (size_t)(u.pm >> 4) * 6144;
#pragma unroll
        for (int ai = 0; ai < 2; ++ai)
#pragma unroll
            for (int m = 0; m < 4; ++m) { const int row = u.pm * BM + ai * HALF + wr * 64 + m * 16 + fr;
                float mean = 0.f, rstd = 1.f; if (stats) { mean = stats[2 * row]; rstd = stats[2 * row + 1]; }
#pragma unroll
                for (int bj = 0; bj < 2; ++bj)
#pragma unroll
                    for (int n = 0; n < 2; ++n) { const int col = cb + bj * HALF + n * 16; const size_t off = (size_t)row * 1024 + col;
                        f32x4 r4 = *(const f32x4*)(src + off);
                        if (stats) { const f32x4 g4 = *(const f32x4*)(lng + col), b4 = *(const f32x4*)(lnb + col); r4 = (r4 - mean) * rstd * g4 + b4; }
                        const f32x4 g1 = *(const f32x4*)(gt + col) + 1.0f;
                        *(f32x4*)(U + off) = r4 * alpha + g1 * acc[ai][bj][m][n]; }
                asm volatile("" ::: "memory"); }
    }
};
template <class Epi, class Sched, bool ALIGN_EPI = false, bool SP2 = false>
__device__ __forceinline__ void gemm_phase(PG8_LAS unsigned char* lds, const Gemm g, const Sched& S, const Epi& E) {
    const int tid = threadIdx.x, wid = __builtin_amdgcn_readfirstlane(tid >> 6), lane = tid & 63, wr = wid >> 2, wc = wid & 3, fr = lane & 15, fq = lane >> 4;
    const int K = g.K, nt = K / BK;
    unsigned voffA[2], voffB[2];
#pragma unroll
    for (int i = 0; i < 2; ++i) { int R, C; stage_rc(tid * 16 + i * 8192, R, C); const int Rb = Epi::PERM ? ((R & ~31) + perm32(R & 31)) : R;
        voffA[i] = (unsigned)(R * K + C) * 2u; voffB[i] = (unsigned)(Rb * K + C) * 2u; }
    const size_t kstep = (size_t)(BK * 2);
    const size_t hstep = (size_t)HALF * K * 2;
    const size_t tstep = 2 * hstep;
    const unsigned ldsw = (unsigned)wid * 1024u;
    const int aoff = lds_byte(wr * 64 + fr, fq * 8), boff = lds_byte(wc * 32 + fr, fq * 8);
#define PG8_SA(b, h) (((b) * 2 + (h)) * HTB)
#define PG8_SB(b, h) ((4 + (b) * 2 + (h)) * HTB)
#define PG8_STAGE(bufoff, gbase, voff) do { _Pragma("unroll") for (int _i = 0; _i < 2; ++_i) \
        __builtin_amdgcn_global_load_lds((const unsigned*)((const char*)(gbase) + (voff)[_i]), (PG8_LAS unsigned*)(lds + (bufoff) + ldsw + _i * 8192), 16, 0, 0); } while (0)
#define PG8_LDA(dst, b, h) do { _Pragma("unroll") for (int m = 0; m < 4; ++m) _Pragma("unroll") for (int k = 0; k < 2; ++k) dst[m][k] = *(const PG8_LAS bf16x8*)(lds + PG8_SA(b, h) + aoff + m * 2048 + k * 1024); } while (0)
#define PG8_LDB(dst, b, h) do { _Pragma("unroll") for (int n = 0; n < 2; ++n) _Pragma("unroll") for (int k = 0; k < 2; ++k) dst[n][k] = *(const PG8_LAS bf16x8*)(lds + PG8_SB(b, h) + boff + n * 2048 + k * 1024); } while (0)
#define PG8_MMA(ai, bj, At, Bt) do { __builtin_amdgcn_s_setprio(1); _Pragma("unroll") for (int m = 0; m < 4; ++m) _Pragma("unroll") for (int n = 0; n < 2; ++n) _Pragma("unroll") for (int k = 0; k < 2; ++k) \
        acc[ai][bj][m][n] = __builtin_amdgcn_mfma_f32_16x16x32_bf16(Bt[n][k], At[m][k], acc[ai][bj][m][n], 0, 0, 0); __builtin_amdgcn_s_setprio(0); } while (0)
#define PG8_WAIT_V(n) asm volatile("s_waitcnt vmcnt(" #n ")" ::: "memory")
#define PG8_WAIT_L(n) asm volatile("s_waitcnt lgkmcnt(" #n ")" ::: "memory")
#define PG8_BAR __builtin_amdgcn_s_barrier()
#define PG8_SCHED __builtin_amdgcn_sched_barrier(0)
    Unit cur, nxt; int ui = 0;
    if (!S.next(0, cur)) return;
    f32x4 acc[2][2][4][2];
#pragma unroll
    for (int a = 0; a < 2; ++a)
#pragma unroll
        for (int b = 0; b < 2; ++b)
#pragma unroll
            for (int m = 0; m < 4; ++m)
#pragma unroll
                for (int n = 0; n < 2; ++n) acc[a][b][m][n] = (f32x4){0.f, 0.f, 0.f, 0.f};
    bf16x8 At[4][2], B0[2][2], B1[2][2];
    const char* cA = (const char*)g.A + (size_t)cur.pm * tstep; const char* cB = (const char*)g.Bt + (size_t)cur.pn * tstep;
    S.a_ready(cur);
    if constexpr (SP2) {
        PG8_STAGE(PG8_SB(0, 0), cB, voffB); PG8_STAGE(PG8_SB(0, 1), cB + hstep, voffB); PG8_STAGE(PG8_SA(0, 0), cA, voffA); PG8_STAGE(PG8_SA(0, 1), cA + hstep, voffA);
        if (wr == 1) PG8_BAR;
        PG8_WAIT_V(2); PG8_BAR;
        PG8_STAGE(PG8_SB(1, 0), cB + kstep, voffB); PG8_STAGE(PG8_SA(1, 0), cA + kstep, voffA); PG8_STAGE(PG8_SB(1, 1), cB + hstep + kstep, voffB);
        PG8_WAIT_V(6); PG8_BAR;
    } else {
        PG8_STAGE(PG8_SB(0, 0), cB, voffB); PG8_STAGE(PG8_SA(0, 0), cA, voffA); PG8_STAGE(PG8_SB(0, 1), cB + hstep, voffB); PG8_STAGE(PG8_SA(0, 1), cA + hstep, voffA);
        if (wr == 1) PG8_BAR;
        PG8_WAIT_V(4); PG8_BAR;
        PG8_STAGE(PG8_SB(1, 0), cB + kstep, voffB); PG8_STAGE(PG8_SA(1, 0), cA + kstep, voffA); PG8_STAGE(PG8_SB(1, 1), cB + hstep + kstep, voffB);
        PG8_WAIT_V(6); PG8_BAR;
    }
    for (;;) {
        const bool has_next = S.next(ui + 1, nxt);
        const char* nA = has_next ? (const char*)g.A + (size_t)nxt.pm * tstep : cA; const char* nB = has_next ? (const char*)g.Bt + (size_t)nxt.pn * tstep : cB;
        for (int t = 0; t < nt; t += 2) {
            const bool last = (t == nt - 2);
            const char* a1 = cA + (size_t)(t + 1) * kstep;
            const char* a2 = last ? nA : cA + (size_t)(t + 2) * kstep; const char* b2 = last ? nB : cB + (size_t)(t + 2) * kstep;
            const char* a3 = a2 + kstep; const char* b3 = b2 + kstep;
            if (last && has_next) S.a_ready(nxt);
            if constexpr (SP2) {
            PG8_LDB(B0, 0, 0); PG8_LDB(B1, 0, 1); PG8_SCHED; PG8_LDA(At, 0, 0); PG8_STAGE(PG8_SA(1, 1), a1 + hstep, voffA);
            PG8_WAIT_V(8); PG8_WAIT_L(0); PG8_BAR; PG8_MMA(0, 0, At, B0); PG8_MMA(0, 1, At, B1); PG8_BAR; PG8_SCHED;
            PG8_LDA(At, 0, 1); PG8_STAGE(PG8_SB(0, 0), b2, voffB); PG8_STAGE(PG8_SB(0, 1), b2 + hstep, voffB); PG8_STAGE(PG8_SA(0, 0), a2, voffA);
            PG8_WAIT_V(8); PG8_WAIT_L(0); PG8_BAR; PG8_MMA(1, 0, At, B0); PG8_MMA(1, 1, At, B1); PG8_BAR; PG8_SCHED;
            PG8_LDB(B0, 1, 0); PG8_LDB(B1, 1, 1); PG8_SCHED; PG8_LDA(At, 1, 0); PG8_STAGE(PG8_SA(0, 1), a2 + hstep, voffA);
            PG8_WAIT_V(8); PG8_WAIT_L(0); PG8_BAR; PG8_MMA(0, 0, At, B0); PG8_MMA(0, 1, At, B1); PG8_BAR; PG8_SCHED;
            PG8_LDA(At, 1, 1); PG8_STAGE(PG8_SB(1, 0), b3, voffB); PG8_STAGE(PG8_SB(1, 1), b3 + hstep, voffB); PG8_STAGE(PG8_SA(1, 0), a3, voffA);
            PG8_WAIT_V(8); PG8_WAIT_L(0); PG8_BAR; PG8_MMA(1, 0, At, B0); PG8_MMA(1, 1, At, B1); PG8_BAR; PG8_SCHED;
            } else {
            PG8_LDB(B0, 0, 0); PG8_SCHED; PG8_LDA(At, 0, 0); PG8_STAGE(PG8_SA(1, 1), a1 + hstep, voffA);
            PG8_WAIT_L(8); PG8_BAR; PG8_WAIT_L(0); PG8_MMA(0, 0, At, B0); PG8_BAR; PG8_SCHED;
            PG8_LDB(B1, 0, 1); PG8_STAGE(PG8_SB(0, 0), b2, voffB);
            PG8_BAR; PG8_WAIT_L(0); PG8_MMA(0, 1, At, B1); PG8_BAR;
            PG8_LDA(At, 0, 1); PG8_STAGE(PG8_SA(0, 0), a2, voffA);
            PG8_BAR; PG8_WAIT_L(0); PG8_MMA(1, 0, At, B0); PG8_BAR; PG8_SCHED;
            PG8_STAGE(PG8_SB(0, 1), b2 + hstep, voffB);
            PG8_WAIT_V(6); PG8_BAR; PG8_MMA(1, 1, At, B1); PG8_BAR;
            PG8_LDB(B0, 1, 0); PG8_SCHED; PG8_LDA(At, 1, 0); PG8_STAGE(PG8_SA(0, 1), a2 + hstep, voffA);
            PG8_WAIT_L(8); PG8_BAR; PG8_WAIT_L(0); PG8_MMA(0, 0, At, B0); PG8_BAR; PG8_SCHED;
            PG8_LDB(B1, 1, 1); PG8_STAGE(PG8_SB(1, 0), b3, voffB);
            PG8_BAR; PG8_WAIT_L(0); PG8_MMA(0, 1, At, B1); PG8_BAR;
            PG8_LDA(At, 1, 1); PG8_STAGE(PG8_SA(1, 0), a3, voffA);
            PG8_BAR; PG8_WAIT_L(0); PG8_MMA(1, 0, At, B0); PG8_BAR; PG8_SCHED;
            PG8_STAGE(PG8_SB(1, 1), b3 + hstep, voffB);
            PG8_WAIT_V(6); PG8_BAR; PG8_MMA(1, 1, At, B1); PG8_BAR;
            }
        }
        if constexpr (ALIGN_EPI) { if (wr == 0) PG8_BAR; }
        if constexpr (!Epi::AFTER_DRAIN) { E(acc, cur, wr, wc, fr, fq); S.done(cur); }
        if (!has_next) break;
#pragma unroll
        for (int a = 0; a < 2; ++a)
#pragma unroll
            for (int b = 0; b < 2; ++b)
#pragma unroll
                for (int m = 0; m < 4; ++m)
#pragma unroll
                    for (int n = 0; n < 2; ++n) acc[a][b][m][n] = (f32x4){0.f, 0.f, 0.f, 0.f};
        cur = nxt; cA = nA; cB = nB; ++ui;
        if constexpr (ALIGN_EPI) { if (wr == 1) PG8_BAR; }
    }
    PG8_WAIT_V(0);
    if constexpr (!ALIGN_EPI) { if (wr == 0) PG8_BAR; }
    PG8_BAR;
    if constexpr (Epi::AFTER_DRAIN) { E.fused(acc, cur, wr, wc, fr, fq, lds, wid, lane); S.done(cur); }
#undef PG8_SA
#undef PG8_SB
#undef PG8_STAGE
#undef PG8_LDA
#undef PG8_LDB
#undef PG8_MMA
#undef PG8_WAIT_V
#undef PG8_WAIT_L
#undef PG8_BAR
#undef PG8_SCHED
}
}
constexpr int NWAVES = 8;
constexpr int N_LAUNCHES = MK_N_LAUNCHES;
constexpr int BATCH = 8, SEQ = 4096, T = BATCH * SEQ, D = 1024, FF = 2816;
constexpr int NAB = 3584, NCD = 3840, NFF2 = 2 * FF, CDO = 768;
constexpr int AB_IN = 3608;
constexpr float LN_EPS = 1e-5f, RES_ALPHA = 1.41421356237309515f;
constexpr int NPHASE = 19;
constexpr int C_QA = 0, C_KA = 256, C_VA = 512, C_RA = 1024, C_QKB = 1536, C_VB = 2560, C_OB = 3072;
constexpr int C_QC = 0, C_KC = 512, C_VC = 1024, C_QD = 1536, C_KD = 2304, C_VD = 3072;
constexpr int MO_SHM = 0, MO_SCM = 1024, MO_GM = 2048, MO_SHF = 3072, MO_SCF = 4096, MO_GF = 5120;

constexpr size_t MiB = 1u << 20;
constexpr size_t WS_CTL = 0, CTL_ZERO_BYTES = 1 * MiB;
constexpr size_t WS_MOD = 1 * MiB;
constexpr size_t WS_STATS = 1 * MiB + 512 * 1024;
constexpr size_t WS_DEN = 2 * MiB;
constexpr size_t WS_G24 = 3 * MiB;
constexpr size_t WS_WAB = 8 * MiB;
constexpr size_t WS_WABO = 15 * MiB;
constexpr size_t WS_WCD = 17 * MiB;
constexpr size_t WS_WCDO = 24 * MiB + 512 * 1024;
constexpr size_t WS_W13 = 26 * MiB;
constexpr size_t WS_W2 = 48 * MiB;
constexpr size_t WS_XN = 60 * MiB;
constexpr size_t WS_MIX = 124 * MiB;
constexpr size_t WS_BIG = 188 * MiB;
constexpr size_t WS_ADEC = 428 * MiB;
constexpr size_t WS_END = 460 * MiB;
constexpr int CW_BAR = 4096;

constexpr int RING_OFF = 0, RING_BYTES = 131072;
constexpr int LDSCTL_OFF = RING_BYTES, MISC_OFF = LDSCTL_OFF + 320;
constexpr int LDS_BYTES = 147456;

__device__ const unsigned char BUCKET[3][132] = {
 {0,1,2,3,4,5,6,7,8,9,10,11,12,13,14,15,16,16,16,16,16,16,17,17,17,17,17,17,17,17,18,18,18,18,18,18,18,18,18,18,19,19,19,19,19,19,19,19,19,19,19,19,19,19,20,20,20,20,20,20,20,20,20,20,20,20,20,20,20,20,20,20,20,21,21,21,21,21,21,21,21,21,21,21,21,21,21,21,21,21,21,21,21,21,21,21,21,21,21,22,22,22,22,22,22,22,22,22,22,22,22,22,22,22,22,22,22,22,22,22,22,22,22,22,22,22,22,22,22,0,0,0},
 {0,4,8,12,16,16,17,17,18,18,19,19,19,19,20,20,20,20,20,21,21,21,21,21,21,22,22,22,22,22,22,22,22,22,23,23,23,23,23,23,23,23,23,23,23,23,24,24,24,24,24,24,24,24,24,24,24,24,24,24,24,24,25,25,25,25,25,25,25,25,25,25,25,25,25,25,25,25,25,25,25,25,25,26,26,26,26,26,26,26,26,26,26,26,26,26,26,26,26,26,26,26,26,26,26,26,26,26,26,26,26,26,26,27,27,27,27,27,27,27,27,27,27,27,27,27,27,27,27,0,0,0},
 {0,16,18,19,20,21,21,22,22,23,23,23,24,24,24,24,25,25,25,25,25,26,26,26,26,26,26,26,26,27,27,27,27,27,27,27,27,27,27,28,28,28,28,28,28,28,28,28,28,28,28,28,29,29,29,29,29,29,29,29,29,29,29,29,29,29,29,29,29,29,30,30,30,30,30,30,30,30,30,30,30,30,30,30,30,30,30,30,30,30,30,30,30,30,30,31,31,31,31,31,31,31,31,31,31,31,31,31,31,31,31,31,31,31,31,31,31,31,31,31,31,31,31,31,31,31,31,31,31,0,0,0}};
#define GAS __attribute__((address_space(1)))
#define LAS __attribute__((address_space(3)))
typedef unsigned short bf16;
typedef unsigned v4u __attribute__((ext_vector_type(4)));
typedef float f32x4 __attribute__((ext_vector_type(4)));
typedef short bf16x8 __attribute__((ext_vector_type(8)));
typedef GAS unsigned gu32;
typedef GAS unsigned long long gu64;
#define RLX_AGENT __ATOMIC_RELAXED, __HIP_MEMORY_SCOPE_AGENT
#define LDS_WAIT() asm volatile("s_waitcnt lgkmcnt(0)" ::: "memory")
#define VM_WAIT() asm volatile("s_waitcnt vmcnt(0)" ::: "memory")
__device__ __forceinline__ unsigned long long rt() { return __builtin_amdgcn_s_memrealtime(); }
__device__ __forceinline__ unsigned f2bf(float f) { unsigned u = __builtin_bit_cast(unsigned, f); return (u + 0x7fffu + ((u >> 16) & 1u)) >> 16; }
__device__ __forceinline__ unsigned pk2(float lo, float hi) { return f2bf(lo) | (f2bf(hi) << 16); }

#define XB_TMO      128
#define XB_XCNT(j)  (256  + 64 * (j))
#define XB_XSUB(j)  (1280 + 64 * (j))
#define XB_XGEN(j)  (2304 + 64 * (j))
#define XB_TOP      3328
#define XB_TOPGEN   3392
#define XCD_BAR_WORDS 3456
#define XB_SPIN_CAP (1u << 23)

__device__ __forceinline__ unsigned xb_ld(unsigned* p)              { return __hip_atomic_load(p, __ATOMIC_RELAXED, __HIP_MEMORY_SCOPE_AGENT); }
__device__ __forceinline__ unsigned xb_add(unsigned* p, unsigned v) { return __hip_atomic_fetch_add(p, v, __ATOMIC_RELAXED, __HIP_MEMORY_SCOPE_AGENT); }
__device__ __forceinline__ unsigned xb_xcc_id() { return (unsigned)__builtin_amdgcn_s_getreg((3 << 11) | 20) & 0xFu; }
#define XB_SPIN(cond, bar) do { unsigned _sp = 0; while (cond) { __builtin_amdgcn_s_sleep(1); \
    if ((++_sp & 255u) == 0u) { if (xb_ld(&(bar)[XB_TMO])) break; if (_sp > XB_SPIN_CAP) { atomicAdd(&(bar)[XB_TMO], 1u); break; } } } } while (0)

struct XcdBarrier {
    unsigned* bar; unsigned x;
    volatile LAS unsigned* st;
};

__device__ __forceinline__ XcdBarrier xcd_barrier_post(unsigned* bar, volatile LAS unsigned* st) {
    XcdBarrier b; b.bar = bar; b.x = xb_xcc_id(); b.st = st;
    if (threadIdx.x == 0) (void)xb_add(&bar[XB_XCNT(b.x)], 1u);
    return b;
}
__device__ __forceinline__ void xcd_barrier_complete(unsigned* bar, unsigned x, unsigned& nloc, unsigned& nx) {
    const unsigned G = gridDim.x * gridDim.y * gridDim.z;
    unsigned sum, cnt, mine, sp = 0u;
    for (;;) {
        sum = 0u; cnt = 0u; mine = 0u;
#pragma unroll
        for (unsigned j = 0; j < 16; ++j) { const unsigned c = xb_ld(&bar[XB_XCNT(j)]); sum += c; cnt += (c > 0u) ? 1u : 0u; mine = (j == x) ? c : mine; }
        if (sum == G) break;
        __builtin_amdgcn_s_sleep(1);
        if ((++sp & 255u) == 0u) { if (xb_ld(&bar[XB_TMO])) break; if (sp > XB_SPIN_CAP) { atomicAdd(&bar[XB_TMO], 1u); break; } }
    }
    nloc = mine > 0u ? mine : 1u; nx = cnt > 0u ? cnt : 1u;
}

__device__ __forceinline__ void xcd_barrier(const XcdBarrier& b) {
    asm volatile("s_waitcnt vmcnt(0)" ::: "memory");
    __syncthreads();
    if (threadIdx.x == 0) {
        unsigned* bar = b.bar;
        __builtin_amdgcn_s_waitcnt(0);
        unsigned nloc = b.st[0], nx = b.st[1];
        if (nloc == 0u) { xcd_barrier_complete(bar, b.x, nloc, nx); b.st[0] = nloc; b.st[1] = nx; }
        const unsigned old = xb_add(&bar[XB_XSUB(b.x)], 1u);
        const unsigned gen = old / nloc;
        if (old + 1u == (gen + 1u) * nloc) {
            __builtin_amdgcn_fence(__ATOMIC_RELEASE, "agent");
            asm volatile("s_waitcnt vmcnt(0)" ::: "memory");
            const unsigned og = xb_add(&bar[XB_TOP], 1u);
            const unsigned tg = og / nx;
            if (og + 1u == (tg + 1u) * nx) xb_add(&bar[XB_TOPGEN], 1u);
            else XB_SPIN(xb_ld(&bar[XB_TOPGEN]) == tg, bar);
            __builtin_amdgcn_fence(__ATOMIC_ACQUIRE, "agent");
            xb_add(&bar[XB_XGEN(b.x)], 1u);
            asm volatile("s_waitcnt vmcnt(0)" ::: "memory");
        } else {
            XB_SPIN(xb_ld(&bar[XB_XGEN(b.x)]) == gen, bar);
            __builtin_amdgcn_fence(__ATOMIC_ACQUIRE, "agent");
            asm volatile("s_waitcnt vmcnt(0)" ::: "memory");
        }
    }
    __syncthreads();
}
struct Args { const float* in[22]; float* out; unsigned char* ws; int ph_lo, ph_hi, li, pad; };
enum { I_X = 0, I_C, I_ADAW, I_ADAB, I_LNG, I_LNB, I_ABWIN, I_WAUP, I_BA, I_GLAG, I_CONVW, I_CONVB, I_BI, I_BF, I_MLG, I_ABWOUT, I_CDWIN, I_RELB, I_CDWOUT, I_W1, I_W3, I_W2 };
struct Frame {
    LAS unsigned char* lds; volatile LAS unsigned* MISC; gu32* ctl;
    int tid, lane, wave, vcu, G;
};
__device__ __forceinline__ float wave_sum(float v) {
#pragma unroll
    for (int o = 1; o < 64; o <<= 1) v += __shfl_xor(v, o);
    return v;
}
__device__ __forceinline__ float bf2f(unsigned short h) { return __uint_as_float((unsigned)h << 16); }
__device__ __forceinline__ float bflo(unsigned w) { return __uint_as_float(w << 16); }
__device__ __forceinline__ float bfhi(unsigned w) { return __uint_as_float(w & 0xffff0000u); }
__device__ __forceinline__ float sigmoid_f(float x) { return __builtin_amdgcn_rcpf(1.0f + __expf(-x)); }
__device__ __forceinline__ float silu2(float x) { return x * sigmoid_f(x); }
__device__ __forceinline__ float logsig_f(float x) { return fminf(x, 0.f) - log1pf(__expf(-fabsf(x))); }
__device__ __forceinline__ float softplus_f(float x) { return fmaxf(x, 0.f) + log1pf(__expf(-fabsf(x))); }

__device__ __forceinline__ void tr_item(const float* W, int ldw, int src_col0, int k0, bf16* WT, int ldt, int dst_row0, LAS float* scr, int lane) {
#pragma unroll 8
    for (int i = 0; i < 32; ++i) { const int kk = 2 * i + (lane >> 5); scr[kk * 33 + (lane & 31)] = W[(size_t)(k0 + kk) * ldw + src_col0 + (lane & 31)]; }
    LDS_WAIT(); asm volatile("" ::: "memory");
    const int c = lane & 7;
#pragma unroll
    for (int j = 0; j < 4; ++j) { const int n = (lane >> 3) + 8 * j; const LAS float* s = scr + (8 * c) * 33 + n;
        v4u o; o.x = pk2(s[0 * 33], s[1 * 33]); o.y = pk2(s[2 * 33], s[3 * 33]); o.z = pk2(s[4 * 33], s[5 * 33]); o.w = pk2(s[6 * 33], s[7 * 33]);
        *(GAS v4u*)(WT + (size_t)(dst_row0 + n) * ldt + k0 + 8 * c) = o; }
    LDS_WAIT(); asm volatile("" ::: "memory");
}
__device__ __forceinline__ void phase_prologue(const Frame& F, const Args& A) {
    unsigned char* ws = A.ws;
    if (F.vcu < 192) {
        LAS float* cact = (LAS float*)(F.lds);
        LAS float* red = (LAS float*)(F.lds + 32768);
        for (int e = F.tid; e < 8192; e += 512) cact[e] = silu2(A.in[I_C][e]);
        __syncthreads();
        for (int it = F.vcu; it < 192; it += F.G) {
            const int l = it / 96, cb = it % 96, col = cb * 64 + F.lane;
            const float* w = A.in[I_ADAW] + (size_t)l * 1024 * 6144 + col;
            float acc[8];
#pragma unroll
            for (int b = 0; b < 8; ++b) acc[b] = 0.f;
            const int kb = F.wave * 128;
#pragma unroll 8
            for (int k = 0; k < 128; ++k) { const float wv = w[(size_t)(kb + k) * 6144];
#pragma unroll
                for (int b = 0; b < 8; ++b) acc[b] += cact[b * 1024 + kb + k] * wv; }
#pragma unroll
            for (int b = 0; b < 8; ++b) red[(F.wave * 8 + b) * 64 + F.lane] = acc[b];
            __syncthreads();
            { const int b = F.wave; float s = A.in[I_ADAB][l * 6144 + col];
#pragma unroll
              for (int w8 = 0; w8 < 8; ++w8) s += red[(w8 * 8 + b) * 64 + F.lane];
              ((float*)(ws + WS_MOD))[(size_t)(l * 8 + b) * 6144 + col] = s; }
            __syncthreads();
        }
    }
    __syncthreads();
    LAS float* scr = (LAS float*)(F.lds + F.wave * 16384);
    const int gw = F.vcu * NWAVES + F.wave, NGW = F.G * NWAVES;
    constexpr int I_A = 112 * 16, I_B = 32 * 16, I_C2 = 120 * 16, I_D = 32 * 12, I_E = 176 * 16 * 2, I_F = 32 * 44 * 2;
    constexpr int NITEMS = I_A + I_B + I_C2 + I_D + I_E + I_F;
    for (int it = gw; it < NITEMS; it += NGW) {
        int r = it;
        if (r < I_A) { const int nb = r / 16, kb = r % 16, d0 = 32 * nb; const int s0 = d0 < 1536 ? d0 : (d0 < 2560 ? 1552 + (d0 - 1536) : (d0 < 3072 ? 2576 + (d0 - 2560) : 3096 + (d0 - 3072)));
            tr_item(A.in[I_ABWIN], AB_IN, s0, 64 * kb, (bf16*)(ws + WS_WAB), 1024, d0, scr, F.lane); continue; } r -= I_A;
        if (r < I_B) { const int nb = r / 16, kb = r % 16; tr_item(A.in[I_ABWOUT], 1024, 32 * nb, 64 * kb, (bf16*)(ws + WS_WABO), 1024, 32 * nb, scr, F.lane); continue; } r -= I_B;
        if (r < I_C2) { const int nb = r / 16, kb = r % 16; tr_item(A.in[I_CDWIN], NCD, 32 * nb, 64 * kb, (bf16*)(ws + WS_WCD), 1024, 32 * nb, scr, F.lane); continue; } r -= I_C2;
        if (r < I_D) { const int nb = r / 12, kb = r % 12; tr_item(A.in[I_CDWOUT], 1024, 32 * nb, 64 * kb, (bf16*)(ws + WS_WCDO), CDO, 32 * nb, scr, F.lane); continue; } r -= I_D;
        if (r < I_E) { const int l = r / (176 * 16), q = r % (176 * 16), nb = q / 16, kb = q % 16, d0 = 32 * nb, pn = d0 >> 8, rr = d0 & 255, bj = rr >> 7, ff0 = 128 * pn + (rr & 127);
            tr_item((bj ? A.in[I_W3] : A.in[I_W1]) + (size_t)l * 1024 * FF, FF, ff0, 64 * kb, (bf16*)(ws + WS_W13) + (size_t)l * NFF2 * 1024, 1024, d0, scr, F.lane); continue; } r -= I_E;
        { const int l = r / (32 * 44), q = r % (32 * 44), nb = q / 44, kb = q % 44;
            tr_item(A.in[I_W2] + (size_t)l * FF * 1024, 1024, 32 * nb, 64 * kb, (bf16*)(ws + WS_W2) + (size_t)l * 1024 * FF, FF, 32 * nb, scr, F.lane); }
    }
}
__device__ __forceinline__ void phase_xn0(const Frame& F, const Args& A) {
    unsigned char* ws = A.ws;
    LAS float* W24 = (LAS float*)F.lds;
    for (int e = F.tid; e < 32 * 1024; e += 512) { const int g = e & 31, k = e >> 5; if (g < 24) { const int sc = g < 16 ? 1536 + g : 3088 + (g - 16); W24[g * 1024 + k] = A.in[I_ABWIN][(size_t)k * AB_IN + sc]; } }
    __syncthreads();
    const float* mod = (const float*)(ws + WS_MOD);
    const int gw = F.vcu * NWAVES + F.wave, NGW = F.G * NWAVES;
    for (int m = gw; m < T; m += NGW) {
        const int b = m >> 12;
        const GAS f32x4* xr = (const GAS f32x4*)(A.in[I_X] + (size_t)m * D) + F.lane;
        const f32x4* scp = (const f32x4*)(mod + (size_t)b * 6144 + MO_SCM) + F.lane; const f32x4* shp = (const f32x4*)(mod + (size_t)b * 6144 + MO_SHM) + F.lane;
        f32x4 v[4];
#pragma unroll
        for (int j = 0; j < 4; ++j) v[j] = xr[64 * j] * (scp[64 * j] + 1.0f) + shp[64 * j];
        GAS unsigned long long* o8 = (GAS unsigned long long*)((bf16*)(ws + WS_XN) + (size_t)m * D) + F.lane;
#pragma unroll
        for (int j = 0; j < 4; ++j) o8[64 * j] = (unsigned long long)pk2(v[j].x, v[j].y) | ((unsigned long long)pk2(v[j].z, v[j].w) << 32);
        float keep = 0.f;
#pragma unroll 4
        for (int g = 0; g < 24; ++g) { float p = 0.f;
#pragma unroll
            for (int j = 0; j < 4; ++j) { const f32x4 w = *(const LAS f32x4*)(W24 + g * 1024 + 256 * j + 4 * F.lane); p += (v[j].x * w.x + v[j].y * w.y) + (v[j].z * w.z + v[j].w * w.w); }
            p = wave_sum(p); if (F.lane == g) keep = p; }
        if (F.lane < 24) ((float*)(ws + WS_G24))[(size_t)m * 24 + F.lane] = keep;
    }
}
template <bool FINAL> __device__ __forceinline__ void phase_ln(const Frame& F, const Args& A, int lnidx, int modl, int mo_sc, int mo_sh) {
    unsigned char* ws = A.ws;
    const float* mod = (const float*)(ws + WS_MOD) + (size_t)modl * 8 * 6144;
    const f32x4* gp = (const f32x4*)(A.in[I_LNG] + lnidx * 1024) + F.lane; const f32x4* bp = (const f32x4*)(A.in[I_LNB] + lnidx * 1024) + F.lane;
    const int gw = F.vcu * NWAVES + F.wave, NGW = F.G * NWAVES;
    for (int m = gw; m < T; m += NGW) {
        const int b = m >> 12;
        GAS f32x4* ur = (GAS f32x4*)(A.out + (size_t)m * D) + F.lane;
        f32x4 v[4]; float s = 0.f;
#pragma unroll
        for (int j = 0; j < 4; ++j) { v[j] = ur[64 * j]; s += (v[j].x + v[j].y) + (v[j].z + v[j].w); }
        const float mean = wave_sum(s) * (1.f / D); float s2 = 0.f;
#pragma unroll
        for (int j = 0; j < 4; ++j) { v[j] = v[j] - mean; s2 += (v[j].x * v[j].x + v[j].y * v[j].y) + (v[j].z * v[j].z + v[j].w * v[j].w); }
        const float rstd = 1.f / sqrtf(wave_sum(s2) * (1.f / D) + LN_EPS);
        if (FINAL) {
#pragma unroll
            for (int j = 0; j < 4; ++j) ur[64 * j] = v[j] * rstd * gp[64 * j] + bp[64 * j];
        } else {
            if (F.lane == 0) { float* st = (float*)(ws + WS_STATS) + 2 * (size_t)m; st[0] = mean; st[1] = rstd; }
            const f32x4* scp = (const f32x4*)(mod + (size_t)b * 6144 + mo_sc) + F.lane; const f32x4* shp = (const f32x4*)(mod + (size_t)b * 6144 + mo_sh) + F.lane;
            GAS unsigned long long* o8 = (GAS unsigned long long*)((bf16*)(ws + WS_XN) + (size_t)m * D) + F.lane;
#pragma unroll
            for (int j = 0; j < 4; ++j) { const f32x4 y = (v[j] * rstd * gp[64 * j] + bp[64 * j]) * (scp[64 * j] + 1.0f) + shp[64 * j];
                o8[64 * j] = (unsigned long long)pk2(y.x, y.y) | ((unsigned long long)pk2(y.z, y.w) << 32); }
        }
    }
}
__device__ __forceinline__ void phase_mix0_pre(const Frame& F, const Args& A) {
    unsigned char* ws = A.ws;
    const bf16* P0 = (const bf16*)(ws + WS_BIG); bf16* QKc = (bf16*)(ws + WS_XN); float* ADEC = (float*)(ws + WS_ADEC); const float* G24 = (const float*)(ws + WS_G24);
    const float* cw = A.in[I_CONVW]; const float* cb = A.in[I_CONVB];
    const int gw = F.vcu * NWAVES + F.wave, NGW = F.G * NWAVES;
    for (int m = gw; m < T; m += NGW) {
        const int t = m & (SEQ - 1);
#pragma unroll
        for (int jj = 0; jj < 4; ++jj) { const int c0 = 256 * jj + 4 * F.lane;
            f32x4 acc = *(const f32x4*)(cb + c0);
#pragma unroll
            for (int j = 0; j < 4; ++j) { const int dt = 3 - j; if (t - dt >= 0) { const uint2 raw = *(const uint2*)(P0 + (size_t)(m - dt) * NAB + C_QKB + c0); const f32x4 w = *(const f32x4*)(cw + j * 1024 + c0);
                    acc.x += bflo(raw.x) * w.x; acc.y += bfhi(raw.x) * w.y; acc.z += bflo(raw.y) * w.z; acc.w += bfhi(raw.y) * w.w; } }
            const float ksc = (c0 >= 512) ? 0.08838834764831845f : 1.0f;
            acc.x = silu2(acc.x) * ksc; acc.y = silu2(acc.y) * ksc; acc.z = silu2(acc.z) * ksc; acc.w = silu2(acc.w) * ksc;
            *(uint2*)(QKc + (size_t)m * 1024 + c0) = make_uint2(pk2(acc.x, acc.y), pk2(acc.z, acc.w)); }
        { const int c0 = 4 * F.lane; f32x4 pre = *(const f32x4*)(A.in[I_BA] + c0);
#pragma unroll
          for (int r = 0; r < 16; ++r) { const float a = G24[(size_t)m * 24 + r]; pre += *(const f32x4*)(A.in[I_WAUP] + r * 256 + c0) * a; }
          f32x4 o; o.x = __expf(logsig_f(pre.x) * 0.0625f); o.y = __expf(logsig_f(pre.y) * 0.0625f); o.z = __expf(logsig_f(pre.z) * 0.0625f); o.w = __expf(logsig_f(pre.w) * 0.0625f);
          *(f32x4*)(ADEC + (size_t)m * 256 + c0) = o; }
    }
}
__device__ __forceinline__ void phase_mix0_rec(const Frame& F, const Args& A) {
    if (F.wave != 0 || F.vcu >= 160) return;
    unsigned char* ws = A.ws;
    const bf16* P0 = (const bf16*)(ws + WS_BIG); const bf16* QKc = (const bf16*)(ws + WS_XN); const float* ADEC = (const float*)(ws + WS_ADEC); const float* G24 = (const float*)(ws + WS_G24);
    float* RAW = A.out; const int lane = F.lane;
    LAS float* L = (LAS float*)F.lds;
    if (F.vcu < 64) {
        const int it = F.vcu, b = it >> 3, h = (it >> 1) & 3, half = it & 1, dv = half * 64 + lane; const size_t r0 = (size_t)b * SEQ;
        LAS float* La = L; LAS float* Lk = L + 1024; LAS float* Lq = L + 2048; LAS float* Lv = L + 3072;
        float S[64];
#pragma unroll
        for (int i = 0; i < 64; ++i) S[i] = 0.f;
        for (int t0 = 0; t0 < SEQ; t0 += 16) {
            { const int st = lane >> 2, sg = lane & 3; const size_t row = r0 + t0 + st;
#pragma unroll
              for (int i = 0; i < 4; ++i) *(LAS f32x4*)(La + st * 64 + sg * 16 + 4 * i) = *(const f32x4*)(ADEC + row * 256 + h * 64 + sg * 16 + 4 * i);
#pragma unroll
              for (int i = 0; i < 2; ++i) { const v4u kk = *(const v4u*)(P0 + row * NAB + C_KA + h * 64 + sg * 16 + 8 * i), qq = *(const v4u*)(P0 + row * NAB + C_QA + h * 64 + sg * 16 + 8 * i);
                  LAS float* pk = Lk + st * 64 + sg * 16 + 8 * i; LAS float* pq = Lq + st * 64 + sg * 16 + 8 * i;
                  pk[0] = bflo(kk.x); pk[1] = bfhi(kk.x); pk[2] = bflo(kk.y); pk[3] = bfhi(kk.y); pk[4] = bflo(kk.z); pk[5] = bfhi(kk.z); pk[6] = bflo(kk.w); pk[7] = bfhi(kk.w);
                  pq[0] = bflo(qq.x); pq[1] = bfhi(qq.x); pq[2] = bflo(qq.y); pq[3] = bfhi(qq.y); pq[4] = bflo(qq.z); pq[5] = bfhi(qq.z); pq[6] = bflo(qq.w); pq[7] = bfhi(qq.w); }
#pragma unroll
              for (int s = 0; s < 16; ++s) Lv[s * 64 + lane] = bf2f(P0[(r0 + t0 + s) * NAB + C_VA + h * 128 + dv]); }
            LDS_WAIT(); asm volatile("" ::: "memory");
#pragma unroll 1
            for (int s = 0; s < 16; ++s) { const float vv = Lv[s * 64 + lane]; float o = 0.f;
#pragma unroll
                for (int k4 = 0; k4 < 16; ++k4) { const f32x4 a = *(const LAS f32x4*)(La + s * 64 + 4 * k4), kk = *(const LAS f32x4*)(Lk + s * 64 + 4 * k4), qq = *(const LAS f32x4*)(Lq + s * 64 + 4 * k4);
                    S[4 * k4 + 0] = a.x * S[4 * k4 + 0] + kk.x * vv; o += qq.x * S[4 * k4 + 0];
                    S[4 * k4 + 1] = a.y * S[4 * k4 + 1] + kk.y * vv; o += qq.y * S[4 * k4 + 1];
                    S[4 * k4 + 2] = a.z * S[4 * k4 + 2] + kk.z * vv; o += qq.z * S[4 * k4 + 2];
                    S[4 * k4 + 3] = a.w * S[4 * k4 + 3] + kk.w * vv; o += qq.w * S[4 * k4 + 3]; }
                RAW[(r0 + t0 + s) * 1024 + h * 128 + dv] = o; }
            LDS_WAIT(); asm volatile("" ::: "memory");
        }
    } else if (F.vcu < 128) {
        const int it = F.vcu - 64, b = it >> 3, h = (it >> 1) & 3, vh = it & 1, vi = vh * 64 + lane; const size_t r0 = (size_t)b * SEQ;
        LAS float* Lk = L; LAS float* Lq = L + 1024; LAS float* Lv = L + 2048; LAS float* Lf = L + 2560;
        const float bi = A.in[I_BI][h], bfv = A.in[I_BF][h];
        float C[128];
#pragma unroll
        for (int i = 0; i < 128; ++i) C[i] = 0.f;
        for (int t0 = 0; t0 < SEQ; t0 += 8) {
            { const int st = lane >> 3, sg = lane & 7; const size_t row = r0 + t0 + st;
#pragma unroll
              for (int i = 0; i < 2; ++i) { const v4u qq = *(const v4u*)(QKc + row * 1024 + h * 128 + sg * 16 + 8 * i), kk = *(const v4u*)(QKc + row * 1024 + 512 + h * 128 + sg * 16 + 8 * i);
                  LAS float* pk = Lk + st * 128 + sg * 16 + 8 * i; LAS float* pq = Lq + st * 128 + sg * 16 + 8 * i;
                  pk[0] = bflo(kk.x); pk[1] = bfhi(kk.x); pk[2] = bflo(kk.y); pk[3] = bfhi(kk.y); pk[4] = bflo(kk.z); pk[5] = bfhi(kk.z); pk[6] = bflo(kk.w); pk[7] = bfhi(kk.w);
                  pq[0] = bflo(qq.x); pq[1] = bfhi(qq.x); pq[2] = bflo(qq.y); pq[3] = bfhi(qq.y); pq[4] = bflo(qq.z); pq[5] = bfhi(qq.z); pq[6] = bflo(qq.w); pq[7] = bfhi(qq.w); }
#pragma unroll
              for (int s = 0; s < 8; ++s) Lv[s * 64 + lane] = bf2f(P0[(r0 + t0 + s) * NAB + C_VB + h * 128 + vi]);
              if (lane < 8) { const size_t rw = r0 + t0 + lane; Lf[2 * lane] = sigmoid_f(G24[rw * 24 + 20 + h] + bfv); Lf[2 * lane + 1] = __expf(G24[rw * 24 + 16 + h] + bi); } }
            LDS_WAIT(); asm volatile("" ::: "memory");
#pragma unroll 1
            for (int s = 0; s < 8; ++s) { const float f = Lf[2 * s], iv = Lf[2 * s + 1] * Lv[s * 64 + lane]; float num = 0.f;
#pragma unroll
                for (int k4 = 0; k4 < 32; ++k4) { const f32x4 kk = *(const LAS f32x4*)(Lk + s * 128 + 4 * k4), qq = *(const LAS f32x4*)(Lq + s * 128 + 4 * k4);
                    C[4 * k4 + 0] = f * C[4 * k4 + 0] + iv * kk.x; num += C[4 * k4 + 0] * qq.x;
                    C[4 * k4 + 1] = f * C[4 * k4 + 1] + iv * kk.y; num += C[4 * k4 + 1] * qq.y;
                    C[4 * k4 + 2] = f * C[4 * k4 + 2] + iv * kk.z; num += C[4 * k4 + 2] * qq.z;
                    C[4 * k4 + 3] = f * C[4 * k4 + 3] + iv * kk.w; num += C[4 * k4 + 3] * qq.w; }
                RAW[(r0 + t0 + s) * 1024 + 512 + h * 128 + vi] = num; }
            LDS_WAIT(); asm volatile("" ::: "memory");
        }
    } else {
        const int it = F.vcu - 128, b = it >> 2, h = it & 3; const size_t r0 = (size_t)b * SEQ;
        const float bi = A.in[I_BI][h], bfv = A.in[I_BF][h]; float* DEN = (float*)(ws + WS_DEN);
        float n0 = 0.f, n1 = 0.f;
        for (int t0 = 0; t0 < SEQ; t0 += 8) {
            float k0[8], k1[8], q0[8], q1[8], ff[8], ii[8];
#pragma unroll
            for (int s = 0; s < 8; ++s) { const size_t row = r0 + t0 + s; q0[s] = bf2f(QKc[row * 1024 + h * 128 + lane]); q1[s] = bf2f(QKc[row * 1024 + h * 128 + 64 + lane]);
                k0[s] = bf2f(QKc[row * 1024 + 512 + h * 128 + lane]); k1[s] = bf2f(QKc[row * 1024 + 512 + h * 128 + 64 + lane]);
                ff[s] = sigmoid_f(G24[row * 24 + 20 + h] + bfv); ii[s] = __expf(G24[row * 24 + 16 + h] + bi); }
#pragma unroll
            for (int s = 0; s < 8; ++s) { n0 = ff[s] * n0 + ii[s] * k0[s]; n1 = ff[s] * n1 + ii[s] * k1[s]; const float d = wave_sum(n0 * q0[s] + n1 * q1[s]); if (lane == 0) DEN[(r0 + t0 + s) * 4 + h] = d; }
        }
    }
}
__device__ __forceinline__ void phase_mix0_post(const Frame& F, const Args& A) {
    unsigned char* ws = A.ws;
    const bf16* P0 = (const bf16*)(ws + WS_BIG); const float* RAW = A.out; const float* DEN = (const float*)(ws + WS_DEN); bf16* MIX = (bf16*)(ws + WS_MIX);
    const int gw = F.vcu * NWAVES + F.wave, NGW = F.G * NWAVES, lane = F.lane;
    for (int m = gw; m < T; m += NGW) {
#pragma unroll
        for (int hh = 0; hh < 8; ++hh) { const int h = hh & 3, ml = hh >> 2, c0 = ml * 512 + h * 128 + 2 * lane;
            float2 x = *(const float2*)(RAW + (size_t)m * 1024 + c0);
            if (ml) { const float dd = fmaxf(fabsf(DEN[(size_t)m * 4 + h]), 1.0f); x.x /= dd; x.y /= dd; }
            const float mean = wave_sum(x.x + x.y) * (1.f / 128.f); x.x -= mean; x.y -= mean;
            const float rstd = 1.f / sqrtf(wave_sum(x.x * x.x + x.y * x.y) * (1.f / 128.f) + LN_EPS);
            const float2 g = *(const float2*)((ml ? A.in[I_MLG] : A.in[I_GLAG]) + h * 128 + 2 * lane);
            const unsigned gr = *(const unsigned*)(P0 + (size_t)m * NAB + (ml ? C_OB : C_RA) + h * 128 + 2 * lane); const float g0 = bflo(gr), g1 = bfhi(gr);
            const float y0 = x.x * rstd * g.x * (ml ? sigmoid_f(g0) : silu2(g0)), y1 = x.y * rstd * g.y * (ml ? sigmoid_f(g1) : silu2(g1));
            *(unsigned*)(MIX + (size_t)m * 1024 + c0) = pk2(y0, y1); }
    }
}
namespace att {
typedef float f32x16 __attribute__((ext_vector_type(16)));
typedef short s16x4 __attribute__((ext_vector_type(4)));
typedef short v4i16_t __attribute__((ext_vector_type(4)));
typedef float f32x2_t __attribute__((ext_vector_type(2))); typedef __bf16 bf16x2_t __attribute__((ext_vector_type(2)));
#define ATT_MFMA(a, b, c) __builtin_amdgcn_mfma_f32_32x32x16_bf16((a), (b), (c), 0, 0, 0)
__device__ __forceinline__ int crow(int r, int hi) { return (r & 3) + 8 * (r >> 2) + 4 * hi; }
__device__ __forceinline__ unsigned off64(unsigned row, unsigned ch) { return 1024u * (row >> 3) + 512u * (ch >> 2) + 64u * (row & 7) + 16u * ((ch & 3) ^ ((row >> 2) & 3)); }
__device__ __forceinline__ unsigned cvtpk(float lo, float hi) { f32x2_t v = {lo, hi}; bf16x2_t b = __builtin_convertvector(v, bf16x2_t); return __builtin_bit_cast(unsigned, b); }
__device__ __forceinline__ bf16x8 packfrag(const f32x16& p, int s) {
    v4u w; w.x = cvtpk(p[8 * s], p[8 * s + 1]); w.y = cvtpk(p[8 * s + 2], p[8 * s + 3]); w.z = cvtpk(p[8 * s + 4], p[8 * s + 5]); w.w = cvtpk(p[8 * s + 6], p[8 * s + 7]);
    return __builtin_bit_cast(bf16x8, w); }
__device__ __forceinline__ s16x4 vtr(const LAS unsigned char* p) { return __builtin_bit_cast(s16x4, __builtin_amdgcn_ds_read_tr16_b64_v4i16((LAS v4i16_t*)p)); }
__device__ __forceinline__ void qkt(f32x16& p0, f32x16& p1, const LAS unsigned char* Kimg, const bf16x8 (&qf)[4], int r32, int hi) {
    p0 = f32x16{}; p1 = f32x16{};
#pragma unroll
    for (int d0 = 0; d0 < 4; ++d0) {
        const bf16x8 k0 = *(const LAS bf16x8*)(Kimg + off64(r32, 2 * d0 + hi)), k1 = *(const LAS bf16x8*)(Kimg + off64(32 + r32, 2 * d0 + hi));
        p0 = ATT_MFMA(k0, qf[d0], p0); p1 = ATT_MFMA(k1, qf[d0], p1); }
}
__device__ __forceinline__ void pv(f32x16 (&o)[2], const f32x16& p0, const f32x16& p1, const LAS unsigned char* Vimg, int lane) {
    const int hi = lane >> 5, blk = (lane >> 4) & 1, q = (lane & 15) >> 2, p = lane & 3;
#pragma unroll
    for (int hf = 0; hf < 2; ++hf)
#pragma unroll
        for (int s = 0; s < 2; ++s) { const bf16x8 pa = packfrag(hf ? p1 : p0, s);
#pragma unroll
            for (int c = 0; c < 2; ++c) { const unsigned R0 = 32 * hf + 16 * s + 4 * hi + q;
                const s16x4 lo = vtr(Vimg + off64(R0, 4 * c + 2 * blk + (p >> 1)) + 8 * (p & 1)), hv = vtr(Vimg + off64(R0 + 8, 4 * c + 2 * blk + (p >> 1)) + 8 * (p & 1));
                const bf16x8 vb = {lo[0], lo[1], lo[2], lo[3], hv[0], hv[1], hv[2], hv[3]};
                o[c] = ATT_MFMA(pa, vb, o[c]); } }
}
struct Stage { v4u k[8], v[8]; };
__device__ __forceinline__ void sb_item(const bf16* P1, bf16* MIX, int b, int h, int qi, LAS unsigned char* Kimg, LAS unsigned char* Vimg, int lane) {
    const int r32 = lane & 31, hi = lane >> 5; const size_t r0 = (size_t)b * SEQ; const int t = 32 * qi + r32;
    bf16x8 qf[4];
#pragma unroll
    for (int d0 = 0; d0 < 4; ++d0) qf[d0] = *(const bf16x8*)(P1 + (r0 + t) * NCD + C_QC + h * 64 + 16 * d0 + 8 * hi);
    f32x16 o[2]; o[0] = f32x16{}; o[1] = f32x16{};
    float accp = 0.f;
    const int srow = lane >> 3, sch = lane & 7;
    Stage st;
    const int kt0 = qi >> 1;
#define SB_LOAD(kt) do { _Pragma("unroll") for (int i = 0; i < 8; ++i) { const bf16* rp = P1 + (r0 + 64 * (kt) + srow + 8 * i) * NCD + h * 64 + 8 * sch; st.k[i] = *(const v4u*)(rp + C_KC); st.v[i] = *(const v4u*)(rp + C_VC); } } while (0)
    SB_LOAD(kt0);
    for (int kt = kt0; kt >= 0; --kt) {
#pragma unroll
        for (int i = 0; i < 8; ++i) { *(LAS v4u*)(Kimg + off64(srow + 8 * i, sch)) = st.k[i]; *(LAS v4u*)(Vimg + off64(srow + 8 * i, sch)) = st.v[i]; }
        if (kt > 0) SB_LOAD(kt - 1);
        f32x16 p0, p1; qkt(p0, p1, Kimg, qf, r32, hi);
        const bool diag = (kt == kt0); const int kb = 64 * kt + 4 * hi;
        f32x16 z0, z1;
#pragma unroll
        for (int r = 0; r < 16; ++r) { z0[r] = p0[r] * 1.4426950408889634f; z1[r] = p1[r] * 1.4426950408889634f; }
        float gs[8];
#pragma unroll
        for (int r = 0; r < 16; ++r) { const int key = kb + (r & 3) + 8 * (r >> 2);
            float s0 = fmaxf(z0[r], 0.f) + __builtin_amdgcn_logf(1.0f + __builtin_amdgcn_exp2f(-fabsf(z0[r])));
            float s1 = fmaxf(z1[r], 0.f) + __builtin_amdgcn_logf(1.0f + __builtin_amdgcn_exp2f(-fabsf(z1[r])));
            if (diag) { if (key >= t) { s0 = 0.f; z0[r] = -1e30f; } if (key + 32 >= t) { s1 = 0.f; z1[r] = -1e30f; } }
            p0[r] = s0; p1[r] = s1; }
#pragma unroll
        for (int g = 0; g < 4; ++g) { gs[g] = (p0[4 * g] + p0[4 * g + 1]) + (p0[4 * g + 2] + p0[4 * g + 3]); gs[4 + g] = (p1[4 * g] + p1[4 * g + 1]) + (p1[4 * g + 2] + p1[4 * g + 3]); }
        float GS[16];
#pragma unroll
        for (int g = 0; g < 8; ++g) { const auto rr = __builtin_amdgcn_permlane32_swap(__float_as_uint(gs[g]), __float_as_uint(gs[g]), false, false); GS[2 * g] = __uint_as_float(rr[0]); GS[2 * g + 1] = __uint_as_float(rr[1]); }
        float E[16]; E[15] = 0.f;
#pragma unroll
        for (int G = 14; G >= 0; --G) E[G] = E[G + 1] + GS[G + 1];
        const float tsum = E[0] + GS[0];
#pragma unroll
        for (int g = 0; g < 8; ++g) { const float base = accp + (hi ? E[2 * g + 1] : E[2 * g]);
            f32x16& P = (g < 4) ? p0 : p1; f32x16& Z = (g < 4) ? z0 : z1; const int rb = 4 * (g & 3);
            const float c3 = base + P[rb + 3], c2 = c3 + P[rb + 2], c1 = c2 + P[rb + 1], c0 = c1 + P[rb];
            P[rb + 3] = __builtin_amdgcn_exp2f(Z[rb + 3] - c3); P[rb + 2] = __builtin_amdgcn_exp2f(Z[rb + 2] - c2); P[rb + 1] = __builtin_amdgcn_exp2f(Z[rb + 1] - c1); P[rb] = __builtin_amdgcn_exp2f(Z[rb] - c0); }
        accp += tsum;
        pv(o, p0, p1, Vimg, lane);
        if (__all(accp >= 150.0f)) break;
    }
#undef SB_LOAD
    bf16* orow = MIX + (r0 + 32 * qi) * CDO + h * 64 + r32;
#pragma unroll
    for (int r = 0; r < 16; ++r) { const int q = crow(r, hi);
        orow[(size_t)q * CDO] = (bf16)(cvtpk(o[0][r], 0.f) & 0xffffu); orow[(size_t)q * CDO + 32] = (bf16)(cvtpk(o[1][r], 0.f) & 0xffffu); }
}
__device__ __forceinline__ void dil_item(const bf16* P1, bf16* MIX, const float* relb, int b, int hg, int r16, int qt, LAS unsigned char* Kimg, LAS unsigned char* Vimg, LAS float* btab, LAS float* wsf, int lane) {
    const int r32 = lane & 31, hi = lane >> 5; const size_t r0 = (size_t)b * SEQ; const int tq = r16 + 16 * (32 * qt + r32);
    const int srow = lane >> 3, sch = lane & 7;
#pragma unroll
    for (int g = 0; g < 3; ++g)
#pragma unroll
        for (int i = 0; i < 3; ++i) { const int d = lane + 64 * i; if (d < 129) btab[g * 132 + d] = relb[BUCKET[g][d] * 12 + g * 4 + hg] * 1.4426950408889634f; }
    f32x16 o[2]; o[0] = f32x16{}; o[1] = f32x16{};
    float m = -1e20f, l = 0.f;
    Stage st;
#pragma unroll 1
    for (int g = 0; g < 3; ++g) { const int sh = 2 * g, rg = r16 & ((1 << sh) - 1), hd = g * 4 + hg, nmax = (SEQ >> sh) - 1;
        bf16x8 qf[4];
#pragma unroll
        for (int d0 = 0; d0 < 4; ++d0) qf[d0] = *(const bf16x8*)(P1 + (r0 + tq) * NCD + C_QD + hd * 64 + 16 * d0 + 8 * hi);
        const int nq = (tq - rg) >> sh;
        const int nq0 = (r16 + 512 * qt - rg) >> sh, nq31 = (r16 + 16 * (32 * qt + 31) - rg) >> sh;
        const int klo = (nq0 - 128 > 0 ? nq0 - 128 : 0) >> 6, khi = nq31 >> 6;
        const LAS float* bt = btab + g * 132;
#define DIL_LOAD(kt) do { _Pragma("unroll") for (int i = 0; i < 8; ++i) { int n_ = 64 * (kt) + srow + 8 * i; n_ = n_ < nmax ? n_ : nmax; const bf16* rp = P1 + (r0 + rg + ((size_t)n_ << sh)) * NCD + hd * 64 + 8 * sch; st.k[i] = *(const v4u*)(rp + C_KD); st.v[i] = *(const v4u*)(rp + C_VD); } } while (0)
        DIL_LOAD(khi);
#pragma unroll 1
        for (int kt = khi; kt >= klo; --kt) {
#pragma unroll
            for (int i = 0; i < 8; ++i) { *(LAS v4u*)(Kimg + off64(srow + 8 * i, sch)) = st.k[i]; *(LAS v4u*)(Vimg + off64(srow + 8 * i, sch)) = st.v[i]; }
            if (kt > klo) DIL_LOAD(kt - 1);
            f32x16 p0, p1; qkt(p0, p1, Kimg, qf, r32, hi);
            const int db = nq - (64 * kt + 4 * hi);
            float mx = -1e30f;
#pragma unroll
            for (int r = 0; r < 16; ++r) { const int d0 = db - ((r & 3) + 8 * (r >> 2)), d1 = d0 - 32;
                const int c0 = d0 < 0 ? 0 : (d0 > 128 ? 128 : d0), c1 = d1 < 0 ? 0 : (d1 > 128 ? 128 : d1);
                float x0 = p0[r] * 1.4426950408889634f + bt[c0], x1 = p1[r] * 1.4426950408889634f + bt[c1];
                x0 = (d0 == c0) ? x0 : -1e30f; x1 = (d1 == c1) ? x1 : -1e30f;
                p0[r] = x0; p1[r] = x1; mx = fmaxf(mx, fmaxf(x0, x1)); }
            { const auto rr = __builtin_amdgcn_permlane32_swap(__float_as_uint(mx), __float_as_uint(mx), false, false); mx = fmaxf(__uint_as_float(rr[0]), __uint_as_float(rr[1])); }
            if (__any(mx > m)) { const float mn = fmaxf(m, mx), f = __builtin_amdgcn_exp2f(m - mn); l *= f; m = mn;
                if (hi == 0) wsf[r32] = f;
                asm volatile("s_waitcnt lgkmcnt(0)" ::: "memory");
#pragma unroll
                for (int r = 0; r < 16; ++r) { const float fr = wsf[crow(r, hi)]; o[0][r] *= fr; o[1][r] *= fr; }
                asm volatile("s_waitcnt lgkmcnt(0)" ::: "memory"); }
            float ls = 0.f;
#pragma unroll
            for (int r = 0; r < 16; ++r) { p0[r] = __builtin_amdgcn_exp2f(p0[r] - m); p1[r] = __builtin_amdgcn_exp2f(p1[r] - m); ls += p0[r] + p1[r]; }
            l += ls;
            pv(o, p0, p1, Vimg, lane);
        }
#undef DIL_LOAD
    }
    { const auto rr = __builtin_amdgcn_permlane32_swap(__float_as_uint(l), __float_as_uint(l), false, false); l = __uint_as_float(rr[0]) + __uint_as_float(rr[1]); }
    if (hi == 0) wsf[32 + r32] = 1.0f / l;
    asm volatile("s_waitcnt lgkmcnt(0)" ::: "memory");
    bf16* orow = MIX + (r0 + r16 + 512 * qt) * CDO + 512 + hg * 64 + r32;
#pragma unroll
    for (int r = 0; r < 16; ++r) { const int q = crow(r, hi); const float il = wsf[32 + q];
        orow[(size_t)(16 * q) * CDO] = (bf16)(cvtpk(o[0][r] * il, 0.f) & 0xffffu); orow[(size_t)(16 * q) * CDO + 32] = (bf16)(cvtpk(o[1][r] * il, 0.f) & 0xffffu); }
    asm volatile("s_waitcnt lgkmcnt(0)" ::: "memory");
}
}
__device__ __forceinline__ void phase_mix1_sb_mfma(const Frame& F, const Args& A) {
    unsigned char* ws = A.ws;
    const bf16* P1 = (const bf16*)(ws + WS_BIG); bf16* MIX = (bf16*)(ws + WS_MIX);
    const int gw = F.vcu * NWAVES + F.wave, NGW = F.G * NWAVES;
    LAS unsigned char* Kimg = F.lds + F.wave * 16384; LAS unsigned char* Vimg = Kimg + 8192;
    for (int it = gw; it < 8192; it += NGW) { const int bh = it & 63, qi = 127 - (it >> 6);
        att::sb_item(P1, MIX, bh >> 3, bh & 7, qi, Kimg, Vimg, F.lane); }
}
__device__ __forceinline__ void phase_mix1_dil_mfma(const Frame& F, const Args& A) {
    unsigned char* ws = A.ws;
    const bf16* P1 = (const bf16*)(ws + WS_BIG); bf16* MIX = (bf16*)(ws + WS_MIX);
    const int gw = F.vcu * NWAVES + F.wave, NGW = F.G * NWAVES;
    LAS unsigned char* Kimg = F.lds + F.wave * 16384; LAS unsigned char* Vimg = Kimg + 8192;
    LAS float* btab = (LAS float*)(F.lds + LDSCTL_OFF + 512 + F.wave * 1856); LAS float* wsf = btab + 400;
    for (int it = gw; it < 4096; it += NGW) { const int qt = 7 - (it >> 9), r16 = (it >> 5) & 15, hg = (it >> 3) & 3, b = it & 7;
        att::dil_item(P1, MIX, A.in[I_RELB], b, hg, r16, qt, Kimg, Vimg, btab, wsf, F.lane); }
}
namespace mx0 {
using att::f32x16; using att::s16x4; using att::off64; using att::vtr; using att::crow; using att::cvtpk; using att::packfrag;
constexpr float LOG2E = 1.4426950408889634f;
constexpr size_t GST_OFF = 0, CST_OFF = (size_t)32 << 20, NST_OFF = (size_t)96 << 20, DEC_OFF = (size_t)97 << 20;
__device__ __forceinline__ unsigned off128(unsigned row, unsigned ch) { return 2048u * (row >> 3) + 512u * (ch >> 2) + 64u * (row & 7) + 16u * ((ch & 3) ^ ((row >> 2) & 3)); }
__device__ __forceinline__ void unpack8(const v4u w, float (&f)[8]) { f[0] = bflo(w.x); f[1] = bfhi(w.x); f[2] = bflo(w.y); f[3] = bfhi(w.y); f[4] = bflo(w.z); f[5] = bfhi(w.z); f[6] = bflo(w.w); f[7] = bfhi(w.w); }
__device__ __forceinline__ v4u pack8(const float (&f)[8]) { v4u w; w.x = cvtpk(f[0], f[1]); w.y = cvtpk(f[2], f[3]); w.z = cvtpk(f[4], f[5]); w.w = cvtpk(f[6], f[7]); return w; }
__device__ __forceinline__ void xty(f32x16 (&out)[2][2], const LAS unsigned char* Ximg, const LAS unsigned char* Yimg, int lane) {
    const int hi = lane >> 5, blk = (lane >> 4) & 1, q = (lane & 15) >> 2, p = lane & 3;
#pragma unroll
    for (int ks = 0; ks < 4; ++ks) { bf16x8 fa[2], fb[2];
#pragma unroll
        for (int ab = 0; ab < 2; ++ab) { const unsigned R = 16 * ks + 8 * hi + q, ch = 4 * ab + 2 * blk + (p >> 1);
            const s16x4 xl = vtr(Ximg + off64(R, ch) + 8 * (p & 1)), xh = vtr(Ximg + off64(R + 4, ch) + 8 * (p & 1)), yl = vtr(Yimg + off64(R, ch) + 8 * (p & 1)), yh = vtr(Yimg + off64(R + 4, ch) + 8 * (p & 1));
            fa[ab] = (bf16x8){xl[0], xl[1], xl[2], xl[3], xh[0], xh[1], xh[2], xh[3]}; fb[ab] = (bf16x8){yl[0], yl[1], yl[2], yl[3], yh[0], yh[1], yh[2], yh[3]}; }
#pragma unroll
        for (int ab = 0; ab < 2; ++ab)
#pragma unroll
            for (int cb = 0; cb < 2; ++cb) out[ab][cb] = ATT_MFMA(fa[ab], fb[cb], out[ab][cb]); }
}
__device__ __forceinline__ void store_tile64(bf16* dst, int ld, const f32x16 (&out)[2][2], int lane) {
    const int r32 = lane & 31, hi = lane >> 5;
#pragma unroll
    for (int ab = 0; ab < 2; ++ab)
#pragma unroll
        for (int cb = 0; cb < 2; ++cb)
#pragma unroll
            for (int r = 0; r < 16; ++r) { int a = 32 * ab + crow(r, hi); asm volatile("" : "+v"(a)); dst[(size_t)a * ld + 32 * cb + r32] = (bf16)(cvtpk(out[ab][cb][r], 0.f) & 0xffffu); }
}
__device__ __forceinline__ float wave_scan(float v, int lane) {
#pragma unroll
    for (int o = 1; o < 64; o <<= 1) { const float u = __shfl_up(v, o); if (lane >= o) v += u; }
    return v;
}
__device__ __forceinline__ float ml_tables(const float* G24, const float* bi, const float* bfp, size_t tb, int h, LAS float* bq, LAS float* bk, LAS float* wt, int lane) {
    const float fb = G24[(tb + lane) * 24 + 20 + h] + bfp[h], ip = (G24[(tb + lane) * 24 + 16 + h] + bi[h]) * LOG2E;
    const float b = wave_scan(logsig_f(fb) * LOG2E, lane), bl = __shfl(b, 63);
    bq[lane] = b; bk[lane] = ip - b; wt[lane] = __builtin_amdgcn_exp2f(bl - b + ip);
    asm volatile("s_waitcnt lgkmcnt(0)" ::: "memory");
    return __builtin_amdgcn_exp2f(bl);
}
}
__device__ __forceinline__ void phase_mix0_pre2(const Frame& F, const Args& A) {
    unsigned char* ws = A.ws;
    const bf16* P0 = (const bf16*)(ws + WS_BIG); bf16* QKc = (bf16*)(ws + WS_XN); float* BCUM = (float*)(ws + WS_ADEC); const float* G24 = (const float*)(ws + WS_G24);
    const float* cw = A.in[I_CONVW]; const float* cb = A.in[I_CONVB];
    const int gw = F.vcu * NWAVES + F.wave, NGW = F.G * NWAVES;
    for (int it = gw; it < 2048; it += NGW) { const int h = it & 3, n = (it >> 2) & 63, b = it >> 8, c = h * 64 + F.lane; const size_t tb = (size_t)b * SEQ + 64 * n;
        float wa[16];
#pragma unroll
        for (int r = 0; r < 16; ++r) wa[r] = A.in[I_WAUP][r * 256 + c];
        const float bav = A.in[I_BA][c]; float run = 0.f;
#pragma unroll 4
        for (int t = 0; t < 64; ++t) { float pre = bav;
#pragma unroll
            for (int r = 0; r < 16; ++r) pre += G24[(tb + t) * 24 + r] * wa[r];
            run += logsig_f(pre) * (0.0625f * mx0::LOG2E); BCUM[(tb + t) * 256 + c] = run; } }
    for (int m = gw; m < T; m += NGW) {
        const int t = m & (SEQ - 1);
#pragma unroll
        for (int jj = 0; jj < 4; ++jj) { const int c0 = 256 * jj + 4 * F.lane;
            f32x4 acc = *(const f32x4*)(cb + c0);
#pragma unroll
            for (int j = 0; j < 4; ++j) { const int dt = 3 - j; if (t - dt >= 0) { const uint2 raw = *(const uint2*)(P0 + (size_t)(m - dt) * NAB + C_QKB + c0); const f32x4 w = *(const f32x4*)(cw + j * 1024 + c0);
                    acc.x += bflo(raw.x) * w.x; acc.y += bfhi(raw.x) * w.y; acc.z += bflo(raw.y) * w.z; acc.w += bfhi(raw.y) * w.w; } }
            const float ksc = (c0 >= 512) ? 0.08838834764831845f : 1.0f;
            acc.x = silu2(acc.x) * ksc; acc.y = silu2(acc.y) * ksc; acc.z = silu2(acc.z) * ksc; acc.w = silu2(acc.w) * ksc;
            *(uint2*)(QKc + (size_t)m * 1024 + c0) = make_uint2(pk2(acc.x, acc.y), pk2(acc.z, acc.w)); }
    }
}
__device__ __forceinline__ void phase_mix0_sum(const Frame& F, const Args& A) {
    unsigned char* ws = A.ws;
    const bf16* P0 = (const bf16*)(ws + WS_BIG); const bf16* QKc = (const bf16*)(ws + WS_XN); const float* BCUM = (const float*)(ws + WS_ADEC); const float* G24 = (const float*)(ws + WS_G24);
    bf16* GST = (bf16*)((unsigned char*)A.out + mx0::GST_OFF); bf16* CST = (bf16*)((unsigned char*)A.out + mx0::CST_OFF); float* NST = (float*)((unsigned char*)A.out + mx0::NST_OFF); float* DEC = (float*)((unsigned char*)A.out + mx0::DEC_OFF);
    const int gw = F.vcu * NWAVES + F.wave, NGW = F.G * NWAVES, lane = F.lane, srow = lane >> 3, sch = lane & 7;
    LAS unsigned char* Ximg = F.lds + F.wave * 16384; LAS unsigned char* Yimg = Ximg + 8192;
    LAS float* tab = (LAS float*)(F.lds + LDSCTL_OFF + 512 + F.wave * 1856);
#define MX0_OUT_ZERO att::f32x16 out[2][2]; _Pragma("unroll") for (int a = 0; a < 2; ++a) _Pragma("unroll") for (int c = 0; c < 2; ++c) out[a][c] = att::f32x16{};
    for (int it = gw; it < 4096; it += NGW) {
        MX0_OUT_ZERO
        { const int dvh = it & 1, ci = it >> 1, h = ci & 3, n = (ci >> 2) & 63, b = ci >> 8; const size_t tb = (size_t)b * SEQ + 64 * n;
            const f32x4 bl0 = *(const f32x4*)(BCUM + (tb + 63) * 256 + h * 64 + 8 * sch), bl1 = *(const f32x4*)(BCUM + (tb + 63) * 256 + h * 64 + 8 * sch + 4);
#pragma unroll
            for (int i = 0; i < 8; ++i) { const size_t row = tb + srow + 8 * i;
                *(LAS v4u*)(Ximg + att::off64(srow + 8 * i, sch)) = *(const v4u*)(P0 + row * NAB + C_VA + h * 128 + 64 * dvh + 8 * sch);
                float k[8]; mx0::unpack8(*(const v4u*)(P0 + row * NAB + C_KA + h * 64 + 8 * sch), k);
                const f32x4 b0 = *(const f32x4*)(BCUM + row * 256 + h * 64 + 8 * sch), b1 = *(const f32x4*)(BCUM + row * 256 + h * 64 + 8 * sch + 4);
#pragma unroll
                for (int e = 0; e < 4; ++e) { k[e] *= __builtin_amdgcn_exp2f(bl0[e] - b0[e]); k[4 + e] *= __builtin_amdgcn_exp2f(bl1[e] - b1[e]); }
                *(LAS v4u*)(Yimg + att::off64(srow + 8 * i, sch)) = mx0::pack8(k); }
            mx0::xty(out, Ximg, Yimg, lane);
            mx0::store_tile64(GST + ((size_t)ci * 128 + 64 * dvh) * 64, 64, out, lane);
        }
        asm volatile("s_waitcnt lgkmcnt(0)" ::: "memory");
    }
    for (int it = 4096 + gw; it < 12288; it += NGW) {
        MX0_OUT_ZERO
        { const int q = it - 4096, dkb = q & 1, dvb = (q >> 1) & 1, ci = q >> 2, h = ci & 3, n = (ci >> 2) & 63, b = ci >> 8; const size_t tb = (size_t)b * SEQ + 64 * n;
            LAS float* bq = tab; LAS float* bk = tab + 64; LAS float* wt = tab + 128;
            const float dec = mx0::ml_tables(G24, A.in[I_BI], A.in[I_BF], tb, h, bq, bk, wt, lane);
#pragma unroll
            for (int i = 0; i < 8; ++i) { const size_t row = tb + srow + 8 * i; const float w = wt[srow + 8 * i];
                float v[8]; mx0::unpack8(*(const v4u*)(P0 + row * NAB + C_VB + h * 128 + 64 * dvb + 8 * sch), v);
#pragma unroll
                for (int e = 0; e < 8; ++e) v[e] *= w;
                *(LAS v4u*)(Ximg + att::off64(srow + 8 * i, sch)) = mx0::pack8(v);
                *(LAS v4u*)(Yimg + att::off64(srow + 8 * i, sch)) = *(const v4u*)(QKc + row * 1024 + 512 + h * 128 + 64 * dkb + 8 * sch); }
            mx0::xty(out, Ximg, Yimg, lane);
            mx0::store_tile64(CST + ((size_t)ci * 128 + 64 * dvb) * 128 + 64 * dkb, 128, out, lane);
            if (dvb == 0) { float nn = 0.f;
#pragma unroll 8
                for (int t = 0; t < 64; ++t) nn += wt[t] * bf2f(*(const LAS unsigned short*)(Yimg + att::off64(t, lane >> 3) + 2 * (lane & 7)));
                NST[(size_t)ci * 128 + 64 * dkb + lane] = nn; if (dkb == 0 && lane == 0) DEC[ci] = dec; }
        }
        asm volatile("s_waitcnt lgkmcnt(0)" ::: "memory");
    }
#undef MX0_ITEM_HEAD
}
__device__ __forceinline__ void phase_mix0_scan(const Frame& F, const Args& A) {
    unsigned char* ws = A.ws; const float* BCUM = (const float*)(ws + WS_ADEC);
    bf16* GST = (bf16*)((unsigned char*)A.out + mx0::GST_OFF); bf16* CST = (bf16*)((unsigned char*)A.out + mx0::CST_OFF); float* NST = (float*)((unsigned char*)A.out + mx0::NST_OFF); const float* DEC = (const float*)((unsigned char*)A.out + mx0::DEC_OFF);
    for (int gi = F.vcu * 512 + F.tid; gi < 131072; gi += F.G * 512) {
        { const int dkp = gi & 31, dv = (gi >> 5) & 127, bh = gi >> 12, b = bh >> 2, h = bh & 3; float s0 = 0.f, s1 = 0.f;
          for (int n0 = 0; n0 < 64; n0 += 8) { unsigned kv[8]; float2 dc[8];
#pragma unroll
              for (int u = 0; u < 8; ++u) { const int ci = (b * 64 + n0 + u) * 4 + h; kv[u] = *(const unsigned*)(GST + ((size_t)ci * 128 + dv) * 64 + 2 * dkp); dc[u] = *(const float2*)(BCUM + ((size_t)b * SEQ + 64 * (n0 + u) + 63) * 256 + h * 64 + 2 * dkp); }
#pragma unroll
              for (int u = 0; u < 8; ++u) { const int ci = (b * 64 + n0 + u) * 4 + h; *(unsigned*)(GST + ((size_t)ci * 128 + dv) * 64 + 2 * dkp) = att::cvtpk(s0, s1);
                  s0 = __builtin_amdgcn_exp2f(dc[u].x) * s0 + bflo(kv[u]); s1 = __builtin_amdgcn_exp2f(dc[u].y) * s1 + bfhi(kv[u]); } } }
        { const int dkq = gi & 31, dv = (gi >> 5) & 127, bh = gi >> 12, b = bh >> 2, h = bh & 3; float s[4] = {0.f, 0.f, 0.f, 0.f}; f32x4 nn = {0.f, 0.f, 0.f, 0.f};
          for (int n0 = 0; n0 < 64; n0 += 8) { uint2 kv[8]; float dc[8]; f32x4 nv[8];
#pragma unroll
              for (int u = 0; u < 8; ++u) { const int ci = (b * 64 + n0 + u) * 4 + h; kv[u] = *(const uint2*)(CST + ((size_t)ci * 128 + dv) * 128 + 4 * dkq); dc[u] = DEC[ci]; if (dv == 0) nv[u] = *(const f32x4*)(NST + (size_t)ci * 128 + 4 * dkq); }
#pragma unroll
              for (int u = 0; u < 8; ++u) { const int ci = (b * 64 + n0 + u) * 4 + h; *(uint2*)(CST + ((size_t)ci * 128 + dv) * 128 + 4 * dkq) = make_uint2(att::cvtpk(s[0], s[1]), att::cvtpk(s[2], s[3]));
                  s[0] = dc[u] * s[0] + bflo(kv[u].x); s[1] = dc[u] * s[1] + bfhi(kv[u].x); s[2] = dc[u] * s[2] + bflo(kv[u].y); s[3] = dc[u] * s[3] + bfhi(kv[u].y);
                  if (dv == 0) { *(f32x4*)(NST + (size_t)ci * 128 + 4 * dkq) = nn; nn = nn * dc[u] + nv[u]; } } } }
    }
}
namespace mx0 {
__device__ __forceinline__ void pv128(f32x16 (&o)[4], const f32x16& p0, const f32x16& p1, bool use1, const LAS unsigned char* Vimg, int lane) {
    const int hi = lane >> 5, blk = (lane >> 4) & 1, q = (lane & 15) >> 2, p = lane & 3;
#pragma unroll
    for (int hf = 0; hf < 2; ++hf) { if (hf == 1 && !use1) break;
#pragma unroll
        for (int s = 0; s < 2; ++s) { const bf16x8 pa = packfrag(hf ? p1 : p0, s);
#pragma unroll
            for (int c = 0; c < 4; ++c) { const unsigned R0 = 32 * hf + 16 * s + 4 * hi + q, ch = 4 * c + 2 * blk + (p >> 1);
                const s16x4 lo = vtr(Vimg + off128(R0, ch) + 8 * (p & 1)), hv = vtr(Vimg + off128(R0 + 8, ch) + 8 * (p & 1));
                const bf16x8 vb = {lo[0], lo[1], lo[2], lo[3], hv[0], hv[1], hv[2], hv[3]};
                o[c] = ATT_MFMA(pa, vb, o[c]); } } }
}
__device__ __forceinline__ float half_sum(float v) {
#pragma unroll
    for (int o = 1; o < 32; o <<= 1) v += __shfl_xor(v, o);
    return v;
}
template <bool SIG> __device__ __forceinline__ void norm_store(f32x16 (&o)[4], const float (&rs)[16], const float* g, const bf16* gsrc, int ldg, bf16* dst, int lane) {
    const int r32 = lane & 31, hi = lane >> 5;
    float gv[4];
#pragma unroll
    for (int c = 0; c < 4; ++c) gv[c] = g[32 * c + r32];
#pragma unroll
    for (int r = 0; r < 16; ++r) { int i = crow(r, hi); asm volatile("" : "+v"(i));
        float x[4]; float s = 0.f, s2 = 0.f;
#pragma unroll
        for (int c = 0; c < 4; ++c) { x[c] = o[c][r] * rs[r]; s += x[c]; s2 += x[c] * x[c]; }
        s = half_sum(s); s2 = half_sum(s2);
        const float mean = s * (1.f / 128.f), var = fmaxf(s2 * (1.f / 128.f) - mean * mean, 0.f), rstd = 1.f / sqrtf(var + LN_EPS);
#pragma unroll
        for (int c = 0; c < 4; ++c) { const float gt = bf2f(gsrc[(size_t)i * ldg + 32 * c + r32]); const float y = (x[c] - mean) * rstd * gv[c] * (SIG ? sigmoid_f(gt) : silu2(gt));
            dst[(size_t)i * 1024 + 32 * c + r32] = (bf16)(cvtpk(y, 0.f) & 0xffffu); } }
}
}
__device__ __forceinline__ void phase_mix0_out(const Frame& F, const Args& A) {
    unsigned char* ws = A.ws;
    const bf16* P0 = (const bf16*)(ws + WS_BIG); const bf16* QKc = (const bf16*)(ws + WS_XN); const float* BCUM = (const float*)(ws + WS_ADEC); const float* G24 = (const float*)(ws + WS_G24); bf16* MIX = (bf16*)(ws + WS_MIX);
    const bf16* GST = (const bf16*)((unsigned char*)A.out + mx0::GST_OFF); const bf16* CST = (const bf16*)((unsigned char*)A.out + mx0::CST_OFF); const float* NST = (const float*)((unsigned char*)A.out + mx0::NST_OFF);
    const int gw = F.vcu * NWAVES + F.wave, NGW = F.G * NWAVES, lane = F.lane, srow = lane >> 3, sch = lane & 7, r32 = lane & 31, hi = lane >> 5;
    LAS unsigned char* img = F.lds + F.wave * 16384;
    LAS float* tab = (LAS float*)(F.lds + LDSCTL_OFF + 512 + F.wave * 1856);
#define MX0_ITEM_HEAD const int ih = it & 1, ci = (it >> 1) & 2047, h = ci & 3, n = (ci >> 2) & 63, b = ci >> 8; const size_t tb = (size_t)b * SEQ + 64 * n; const int iq = 32 * ih + r32; \
        att::f32x16 o[4]; _Pragma("unroll") for (int c = 0; c < 4; ++c) o[c] = att::f32x16{};
    for (int it = gw; it < 4096; it += NGW) {
        MX0_ITEM_HEAD
        {
            bf16x8 qf[4];
#pragma unroll
            for (int d0 = 0; d0 < 4; ++d0) { float q[8]; mx0::unpack8(*(const v4u*)(P0 + (tb + iq) * NAB + C_QA + h * 64 + 16 * d0 + 8 * hi), q);
                const f32x4 b0 = *(const f32x4*)(BCUM + (tb + iq) * 256 + h * 64 + 16 * d0 + 8 * hi), b1 = *(const f32x4*)(BCUM + (tb + iq) * 256 + h * 64 + 16 * d0 + 8 * hi + 4);
#pragma unroll
                for (int e = 0; e < 4; ++e) { q[e] *= __builtin_amdgcn_exp2f(b0[e]); q[4 + e] *= __builtin_amdgcn_exp2f(b1[e]); }
                qf[d0] = __builtin_bit_cast(bf16x8, mx0::pack8(q)); }
#pragma unroll
            for (int i = 0; i < 8; ++i) { const size_t row = tb + srow + 8 * i;
                float k[8]; mx0::unpack8(*(const v4u*)(P0 + row * NAB + C_KA + h * 64 + 8 * sch), k);
                const f32x4 b0 = *(const f32x4*)(BCUM + row * 256 + h * 64 + 8 * sch), b1 = *(const f32x4*)(BCUM + row * 256 + h * 64 + 8 * sch + 4);
#pragma unroll
                for (int e = 0; e < 4; ++e) { k[e] *= __builtin_amdgcn_exp2f(-b0[e]); k[4 + e] *= __builtin_amdgcn_exp2f(-b1[e]); }
                *(LAS v4u*)(img + att::off64(srow + 8 * i, sch)) = mx0::pack8(k); }
            att::f32x16 p0, p1; att::qkt(p0, p1, img, qf, r32, hi);
#pragma unroll
            for (int r = 0; r < 16; ++r) { const int j = att::crow(r, hi); if (j > iq) p0[r] = 0.f; if (j + 32 > iq) p1[r] = 0.f; }
#pragma unroll
            for (int i = 0; i < 16; ++i) { const int e = lane + 64 * i, row = e >> 4, ch = e & 15;
                *(LAS v4u*)(img + mx0::off128(row, ch)) = *(const v4u*)(P0 + (tb + row) * NAB + C_VA + h * 128 + 8 * ch); }
            mx0::pv128(o, p0, p1, ih == 1, img, lane);
#pragma unroll
            for (int d0 = 0; d0 < 4; ++d0)
#pragma unroll
                for (int c = 0; c < 4; ++c) { const bf16x8 sb = *(const bf16x8*)(GST + ((size_t)ci * 128 + 32 * c + r32) * 64 + 16 * d0 + 8 * hi); o[c] = ATT_MFMA(qf[d0], sb, o[c]); }
            float rs[16];
#pragma unroll
            for (int r = 0; r < 16; ++r) rs[r] = 1.0f;
            mx0::norm_store<false>(o, rs, A.in[I_GLAG] + h * 128, P0 + (tb + 32 * ih) * NAB + C_RA + h * 128, NAB, MIX + (tb + 32 * ih) * 1024 + h * 128, lane);
        }
        asm volatile("s_waitcnt lgkmcnt(0)" ::: "memory");
    }
    for (int it = 4096 + gw; it < 8192; it += NGW) {
        MX0_ITEM_HEAD
        {
            LAS float* bq = tab; LAS float* bk = tab + 64; LAS float* wt = tab + 128; LAS float* npv = tab + 192; LAS float* wsf = tab + 320;
            (void)mx0::ml_tables(G24, A.in[I_BI], A.in[I_BF], tb, h, bq, bk, wt, lane);
            npv[lane] = NST[(size_t)ci * 128 + lane]; npv[64 + lane] = NST[(size_t)ci * 128 + 64 + lane];
            bf16x8 qf[8];
#pragma unroll
            for (int d0 = 0; d0 < 8; ++d0) qf[d0] = *(const bf16x8*)(QKc + (tb + iq) * 1024 + h * 128 + 16 * d0 + 8 * hi);
#pragma unroll
            for (int i = 0; i < 16; ++i) { const int e = lane + 64 * i, row = e >> 4, ch = e & 15;
                *(LAS v4u*)(img + mx0::off128(row, ch)) = *(const v4u*)(QKc + (tb + row) * 1024 + 512 + h * 128 + 8 * ch); }
            att::f32x16 p0 = att::f32x16{}, p1 = att::f32x16{};
#pragma unroll
            for (int d0 = 0; d0 < 8; ++d0) { const bf16x8 k0 = *(const LAS bf16x8*)(img + mx0::off128(r32, 2 * d0 + hi)); p0 = ATT_MFMA(k0, qf[d0], p0);
                if (ih == 1) { const bf16x8 k1 = *(const LAS bf16x8*)(img + mx0::off128(32 + r32, 2 * d0 + hi)); p1 = ATT_MFMA(k1, qf[d0], p1); } }
            asm volatile("s_waitcnt lgkmcnt(0)" ::: "memory");
            const float bi_ = bq[iq]; float dpart = 0.f;
#pragma unroll
            for (int r = 0; r < 16; ++r) { const int j = att::crow(r, hi);
                const float a0 = (j <= iq) ? p0[r] * __builtin_amdgcn_exp2f(bi_ + bk[j]) : 0.f, a1 = (j + 32 <= iq) ? p1[r] * __builtin_amdgcn_exp2f(bi_ + bk[j + 32]) : 0.f;
                p0[r] = a0; p1[r] = a1; dpart += a0 + a1; }
#pragma unroll
            for (int i = 0; i < 16; ++i) { const int e = lane + 64 * i, row = e >> 4, ch = e & 15;
                *(LAS v4u*)(img + mx0::off128(row, ch)) = *(const v4u*)(P0 + (tb + row) * NAB + C_VB + h * 128 + 8 * ch); }
            mx0::pv128(o, p0, p1, ih == 1, img, lane);
            const float qsc = __builtin_amdgcn_exp2f(bi_);
#pragma unroll
            for (int d0 = 0; d0 < 8; ++d0) { float q[8]; mx0::unpack8(__builtin_bit_cast(v4u, qf[d0]), q);
                const f32x4 n0 = *(const LAS f32x4*)(npv + 16 * d0 + 8 * hi), n1 = *(const LAS f32x4*)(npv + 16 * d0 + 8 * hi + 4);
#pragma unroll
                for (int e = 0; e < 8; ++e) q[e] *= qsc;
                dpart += (q[0] * n0[0] + q[1] * n0[1]) + (q[2] * n0[2] + q[3] * n0[3]) + (q[4] * n1[0] + q[5] * n1[1]) + (q[6] * n1[2] + q[7] * n1[3]);
                const bf16x8 qs = __builtin_bit_cast(bf16x8, mx0::pack8(q));
#pragma unroll
                for (int c = 0; c < 4; ++c) { const bf16x8 cb = *(const bf16x8*)(CST + ((size_t)ci * 128 + 32 * c + r32) * 128 + 16 * d0 + 8 * hi); o[c] = ATT_MFMA(qs, cb, o[c]); } }
            { const auto rr = __builtin_amdgcn_permlane32_swap(__float_as_uint(dpart), __float_as_uint(dpart), false, false); dpart = __uint_as_float(rr[0]) + __uint_as_float(rr[1]); }
            if (hi == 0) wsf[r32] = 1.0f / fmaxf(fabsf(dpart), 1.0f);
            asm volatile("s_waitcnt lgkmcnt(0)" ::: "memory");
            float rs[16];
#pragma unroll
            for (int r = 0; r < 16; ++r) rs[r] = wsf[att::crow(r, hi)];
            mx0::norm_store<true>(o, rs, A.in[I_MLG] + h * 128, P0 + (tb + 32 * ih) * NAB + C_OB + h * 128, NAB, MIX + (tb + 32 * ih) * 1024 + 512 + h * 128, lane);
        }
        asm volatile("s_waitcnt lgkmcnt(0)" ::: "memory");
    }
#undef MX0_ITEM_HEAD
}
__device__ __forceinline__ void phase_mix1_sb(const Frame& F, const Args& A) {
    unsigned char* ws = A.ws;
    const bf16* P1 = (const bf16*)(ws + WS_BIG); bf16* MIX = (bf16*)(ws + WS_MIX);
    const int gw = F.vcu * NWAVES + F.wave, NGW = F.G * NWAVES, lane = F.lane;
    LAS unsigned* LK = (LAS unsigned*)(F.lds + F.wave * 16384); LAS unsigned* LV = LK + 2048;
    for (int it0 = gw; it0 < 2048; it0 += NGW)
    for (int pass = 0; pass < 2; ++pass) {
        const int it = pass ? 4095 - it0 : it0; const int bh = it & 63, qblk = it >> 6, b = bh >> 3, h = bh & 7;
        const size_t r0 = (size_t)b * SEQ; const int t = qblk * 64 + lane;
        float q[64], o[64];
#pragma unroll
        for (int i = 0; i < 8; ++i) { const v4u w = *(const v4u*)(P1 + (r0 + t) * NCD + C_QC + h * 64 + 8 * i);
            q[8 * i] = bflo(w.x); q[8 * i + 1] = bfhi(w.x); q[8 * i + 2] = bflo(w.y); q[8 * i + 3] = bfhi(w.y); q[8 * i + 4] = bflo(w.z); q[8 * i + 5] = bfhi(w.z); q[8 * i + 6] = bflo(w.w); q[8 * i + 7] = bfhi(w.w); }
#pragma unroll
        for (int i = 0; i < 64; ++i) o[i] = 0.f;
        float accs = 0.f;
        for (int kt = qblk; kt >= 0; --kt) {
#pragma unroll
            for (int i = 0; i < 8; ++i) { *(LAS v4u*)(LK + lane * 32 + 4 * i) = *(const v4u*)(P1 + (r0 + kt * 64 + lane) * NCD + C_KC + h * 64 + 8 * i);
                                          *(LAS v4u*)(LV + lane * 32 + 4 * i) = *(const v4u*)(P1 + (r0 + kt * 64 + lane) * NCD + C_VC + h * 64 + 8 * i); }
            LDS_WAIT(); asm volatile("" ::: "memory");
#pragma unroll 1
            for (int sl = 63; sl >= 0; --sl) { const int s = kt * 64 + sl; float z = 0.f;
#pragma unroll
                for (int i = 0; i < 8; ++i) { const v4u w = *(const LAS v4u*)(LK + sl * 32 + 4 * i);
                    z += q[8 * i] * bflo(w.x) + q[8 * i + 1] * bfhi(w.x) + q[8 * i + 2] * bflo(w.y) + q[8 * i + 3] * bfhi(w.y) + q[8 * i + 4] * bflo(w.z) + q[8 * i + 5] * bfhi(w.z) + q[8 * i + 6] * bflo(w.w) + q[8 * i + 7] * bfhi(w.w); }
                float p = 0.f;
                if (s < t) { accs += softplus_f(z); p = __expf(z - accs); }
#pragma unroll
                for (int i = 0; i < 8; ++i) { const v4u w = *(const LAS v4u*)(LV + sl * 32 + 4 * i);
                    o[8 * i] += p * bflo(w.x); o[8 * i + 1] += p * bfhi(w.x); o[8 * i + 2] += p * bflo(w.y); o[8 * i + 3] += p * bfhi(w.y); o[8 * i + 4] += p * bflo(w.z); o[8 * i + 5] += p * bfhi(w.z); o[8 * i + 6] += p * bflo(w.w); o[8 * i + 7] += p * bfhi(w.w); } }
            LDS_WAIT(); asm volatile("" ::: "memory");
            if (__all(accs >= 104.0f)) break;
        }
#pragma unroll
        for (int i = 0; i < 8; ++i) { v4u w; w.x = pk2(o[8 * i], o[8 * i + 1]); w.y = pk2(o[8 * i + 2], o[8 * i + 3]); w.z = pk2(o[8 * i + 4], o[8 * i + 5]); w.w = pk2(o[8 * i + 6], o[8 * i + 7]);
            *(v4u*)(MIX + (r0 + t) * CDO + h * 64 + 8 * i) = w; }
    }
}
__device__ __forceinline__ void phase_mix1_dil(const Frame& F, const Args& A) {
    unsigned char* ws = A.ws;
    const bf16* P1 = (const bf16*)(ws + WS_BIG); bf16* MIX = (bf16*)(ws + WS_MIX); const float* relb = A.in[I_RELB];
    for (int gi = F.vcu * 512 + F.tid; gi < BATCH * 4 * SEQ; gi += F.G * 512) {
        const int t = gi & (SEQ - 1), hg = (gi >> 12) & 3, b = gi >> 14; const size_t r0 = (size_t)b * SEQ;
        float o[64]; float mx = -1e30f, l = 0.f;
#pragma unroll
        for (int i = 0; i < 64; ++i) o[i] = 0.f;
#pragma unroll 1
        for (int g = 0; g < 3; ++g) { const int dil = g == 0 ? 1 : (g == 1 ? 4 : 16), hd = g * 4 + hg;
            float q[64];
#pragma unroll
            for (int i = 0; i < 8; ++i) { const v4u w = *(const v4u*)(P1 + (r0 + t) * NCD + C_QD + hd * 64 + 8 * i);
                q[8 * i] = bflo(w.x); q[8 * i + 1] = bfhi(w.x); q[8 * i + 2] = bflo(w.y); q[8 * i + 3] = bfhi(w.y); q[8 * i + 4] = bflo(w.z); q[8 * i + 5] = bfhi(w.z); q[8 * i + 6] = bflo(w.w); q[8 * i + 7] = bfhi(w.w); }
#pragma unroll 1
            for (int j = 0; j <= 128; ++j) { const int p = t - j * dil; if (p < 0) break;
                float z = relb[BUCKET[g][j] * 12 + hd];
#pragma unroll
                for (int i = 0; i < 8; ++i) { const v4u w = *(const v4u*)(P1 + (r0 + p) * NCD + C_KD + hd * 64 + 8 * i);
                    z += q[8 * i] * bflo(w.x) + q[8 * i + 1] * bfhi(w.x) + q[8 * i + 2] * bflo(w.y) + q[8 * i + 3] * bfhi(w.y) + q[8 * i + 4] * bflo(w.z) + q[8 * i + 5] * bfhi(w.z) + q[8 * i + 6] * bflo(w.w) + q[8 * i + 7] * bfhi(w.w); }
                const float mn = fmaxf(mx, z), al = __expf(mx - mn), pe = __expf(z - mn); mx = mn; l = l * al + pe;
#pragma unroll
                for (int i = 0; i < 8; ++i) { const v4u w = *(const v4u*)(P1 + (r0 + p) * NCD + C_VD + hd * 64 + 8 * i);
                    o[8 * i] = o[8 * i] * al + pe * bflo(w.x); o[8 * i + 1] = o[8 * i + 1] * al + pe * bfhi(w.x); o[8 * i + 2] = o[8 * i + 2] * al + pe * bflo(w.y); o[8 * i + 3] = o[8 * i + 3] * al + pe * bfhi(w.y);
                    o[8 * i + 4] = o[8 * i + 4] * al + pe * bflo(w.z); o[8 * i + 5] = o[8 * i + 5] * al + pe * bfhi(w.z); o[8 * i + 6] = o[8 * i + 6] * al + pe * bflo(w.w); o[8 * i + 7] = o[8 * i + 7] * al + pe * bfhi(w.w); } }
        }
        const float il = 1.0f / l;
#pragma unroll
        for (int i = 0; i < 8; ++i) { v4u w; w.x = pk2(o[8 * i] * il, o[8 * i + 1] * il); w.y = pk2(o[8 * i + 2] * il, o[8 * i + 3] * il); w.z = pk2(o[8 * i + 4] * il, o[8 * i + 5] * il); w.w = pk2(o[8 * i + 6] * il, o[8 * i + 7] * il);
            *(v4u*)(MIX + (r0 + t) * CDO + 512 + hg * 64 + 8 * i) = w; }
    }
}

__global__ void __launch_bounds__(NWAVES * 64, 2) fwd_kernel(Args args) {
    extern __shared__ __attribute__((aligned(16))) unsigned char lds[];
    Frame F;
    F.lds = (LAS unsigned char*)lds;
    F.MISC = (volatile LAS unsigned*)(F.lds + MISC_OFF);
    F.tid = threadIdx.x; F.lane = F.tid & 63; F.wave = __builtin_amdgcn_readfirstlane(F.tid >> 6);
    F.G = gridDim.x; { const int bx = blockIdx.x; F.vcu = (F.G % 8 == 0) ? (bx % 8) * (F.G / 8) + bx / 8 : bx; }
    unsigned char* ws = args.ws;
    F.ctl = (gu32*)(ws + WS_CTL);
    for (int u = F.tid; u < (LDS_BYTES - LDSCTL_OFF) / 4; u += NWAVES * 64) ((LAS unsigned*)(F.lds + LDSCTL_OFF))[u] = 0u;
    __syncthreads();
    XcdBarrier bar; bar.bar = (unsigned*)(F.ctl + CW_BAR); bar.x = 0; bar.st = nullptr;
    if (N_LAUNCHES == 1) bar = xcd_barrier_post((unsigned*)(F.ctl + CW_BAR), F.MISC + 8);
    const int lo = args.ph_lo, hi = args.ph_hi;
#define IN(k) (lo <= (k) && (k) < hi)
#define SEAM(k) do { if (IN(k) && IN((k) + 1)) xcd_barrier(bar); } while (0)
    bf16* XN = (bf16*)(ws + WS_XN); bf16* MIX = (bf16*)(ws + WS_MIX); bf16* BIG = (bf16*)(ws + WS_BIG);
    const float* MOD = (const float*)(ws + WS_MOD); const float* STATS = (const float*)(ws + WS_STATS);
    const float* LNG = args.in[I_LNG]; const float* LNB = args.in[I_LNB];
    if (IN(0)) { phase_prologue(F, args); } SEAM(0);
    if (IN(1)) { phase_xn0(F, args); } SEAM(1);
    if (IN(2)) { pg8::Gemm g{XN, (const bf16*)(ws + WS_WAB), T, NAB, D}; pg8::StaticOrder S; S.init(T, NAB, F.G, (int)blockIdx.x);
        pg8::EpiBf16S E{BIG, NAB, 0x1u};
        pg8::gemm_phase<pg8::EpiBf16S, pg8::StaticOrder, true, true>(F.lds + RING_OFF, g, S, E); } SEAM(2);
    if (IN(3)) { if (MIX0_MFMA) phase_mix0_pre2(F, args); else phase_mix0_pre(F, args); } SEAM(3);
    if (IN(4)) { if (MIX0_MFMA) phase_mix0_sum(F, args); else phase_mix0_rec(F, args); } SEAM(4);
    if (IN(5)) { if (MIX0_MFMA) phase_mix0_scan(F, args); } SEAM(5);
    if (IN(6)) { if (MIX0_MFMA) phase_mix0_out(F, args); else phase_mix0_post(F, args); } SEAM(6);
    if (IN(7)) { pg8::Gemm g{MIX, (const bf16*)(ws + WS_WABO), T, D, D}; pg8::StaticOrder S; S.init(T, D, F.G, (int)blockIdx.x);
        pg8::EpiRes E{args.in[I_X], args.out, nullptr, nullptr, nullptr, MOD + MO_GM, RES_ALPHA};
        pg8::gemm_phase<pg8::EpiRes, pg8::StaticOrder, true, true>(F.lds + RING_OFF, g, S, E); } SEAM(7);
    if (IN(8)) { phase_ln<false>(F, args, 0, 0, MO_SCF, MO_SHF); } SEAM(8);
    if (IN(9)) { pg8::Gemm g{XN, (const bf16*)(ws + WS_W13), T, NFF2, D}; pg8::StaticOrder S; S.init(T, NFF2, F.G, (int)blockIdx.x);
        pg8::EpiSwiglu E{BIG, FF};
        pg8::gemm_phase<pg8::EpiSwiglu, pg8::StaticOrder, true, true>(F.lds + RING_OFF, g, S, E); } SEAM(9);
    if (IN(10)) { pg8::Gemm g{BIG, (const bf16*)(ws + WS_W2), T, D, FF}; pg8::StaticOrder S; S.init(T, D, F.G, (int)blockIdx.x);
        pg8::EpiRes E{args.out, args.out, STATS, LNG + 0 * 1024, LNB + 0 * 1024, MOD + MO_GF, RES_ALPHA};
        pg8::gemm_phase<pg8::EpiRes, pg8::StaticOrder, true, true>(F.lds + RING_OFF, g, S, E); } SEAM(10);
    if (IN(11)) { phase_ln<false>(F, args, 1, 1, MO_SCM, MO_SHM); } SEAM(11);
    if (IN(12)) { pg8::Gemm g{XN, (const bf16*)(ws + WS_WCD), T, NCD, D}; pg8::StaticOrder S; S.init(T, NCD, F.G, (int)blockIdx.x);
        pg8::EpiBf16S E{BIG, NCD, 0x1C3u};
        pg8::gemm_phase<pg8::EpiBf16S, pg8::StaticOrder, true, true>(F.lds + RING_OFF, g, S, E); } SEAM(12);
    if (IN(13)) { if (MIX1_MFMA & 1) phase_mix1_sb_mfma(F, args); else phase_mix1_sb(F, args); if (MIX1_MFMA & 2) phase_mix1_dil_mfma(F, args); else phase_mix1_dil(F, args); } SEAM(13);
    if (IN(14)) { pg8::Gemm g{MIX, (const bf16*)(ws + WS_WCDO), T, D, CDO}; pg8::StaticOrder S; S.init(T, D, F.G, (int)blockIdx.x);
        pg8::EpiRes E{args.out, args.out, STATS, LNG + 1 * 1024, LNB + 1 * 1024, MOD + 8 * 6144 + MO_GM, RES_ALPHA};
        pg8::gemm_phase<pg8::EpiRes, pg8::StaticOrder, true, true>(F.lds + RING_OFF, g, S, E); } SEAM(14);
    if (IN(15)) { phase_ln<false>(F, args, 2, 1, MO_SCF, MO_SHF); } SEAM(15);
    if (IN(16)) { pg8::Gemm g{XN, (const bf16*)(ws + WS_W13) + (size_t)NFF2 * 1024, T, NFF2, D}; pg8::StaticOrder S; S.init(T, NFF2, F.G, (int)blockIdx.x);
        pg8::EpiSwiglu E{BIG, FF};
        pg8::gemm_phase<pg8::EpiSwiglu, pg8::StaticOrder, true, true>(F.lds + RING_OFF, g, S, E); } SEAM(16);
    if (IN(17)) { pg8::Gemm g{BIG, (const bf16*)(ws + WS_W2) + (size_t)1024 * FF, T, D, FF}; pg8::StaticOrder S; S.init(T, D, F.G, (int)blockIdx.x);
        pg8::EpiRes E{args.out, args.out, STATS, LNG + 2 * 1024, LNB + 2 * 1024, MOD + 8 * 6144 + MO_GF, RES_ALPHA};
        pg8::gemm_phase<pg8::EpiRes, pg8::StaticOrder, true, true>(F.lds + RING_OFF, g, S, E); } SEAM(17);
    if (IN(18)) { phase_ln<true>(F, args, 3, 0, 0, 0); }
#undef IN
#undef SEAM
}

extern "C" void kernel_launch(void* const* d_in, const int* in_sizes, int n_in, void* d_out, int out_size, void* d_ws, size_t ws_size, hipStream_t stream) {
    static int grid = 0;
    if (grid == 0) {
        if (n_in != 22 || in_sizes[0] != T * D || out_size != T * D || ws_size < WS_END) { fprintf(stderr, "kernel_launch: unexpected shapes (n_in %d, in0 %d, out %d, ws %zu); nothing launched\n", n_in, n_in > 0 ? in_sizes[0] : -1, out_size, ws_size); grid = -1; return; }
        int dev = 0, cus = 0, per_cu = 0;
        if (hipGetDevice(&dev) != hipSuccess || hipDeviceGetAttribute(&cus, hipDeviceAttributeMultiprocessorCount, dev) != hipSuccess) { grid = -1; return; }
        if (hipFuncSetAttribute((const void*)fwd_kernel, hipFuncAttributeMaxDynamicSharedMemorySize, LDS_BYTES) != hipSuccess) { fprintf(stderr, "kernel_launch: hipFuncSetAttribute failed\n"); grid = -1; return; }
        if (hipOccupancyMaxActiveBlocksPerMultiprocessor(&per_cu, (const void*)fwd_kernel, NWAVES * 64, LDS_BYTES) != hipSuccess || per_cu < 1) fprintf(stderr, "kernel_launch: occupancy query reports %d workgroups per CU\n", per_cu);
        (void)hipGetLastError();
        grid = cus;
    }
    if (grid < 0) return;
    if (hipMemsetAsync((char*)d_ws + WS_CTL, 0, CTL_ZERO_BYTES, stream) != hipSuccess) { fprintf(stderr, "kernel_launch: hipMemsetAsync failed\n"); return; }
    Args a{};
    for (int i = 0; i < 22; ++i) a.in[i] = (const float*)d_in[i];
    a.out = (float*)d_out; a.ws = (unsigned char*)d_ws;
    if (N_LAUNCHES == 1) { a.ph_lo = 0; a.ph_hi = NPHASE; a.li = 0; hipLaunchKernelGGL(fwd_kernel, dim3(grid), dim3(NWAVES * 64), LDS_BYTES, stream, a); }
    else for (int li = 0; li < NPHASE; ++li) { a.ph_lo = li; a.ph_hi = li + 1; a.li = li; hipLaunchKernelGGL(fwd_kernel, dim3(grid), dim3(NWAVES * 64), LDS_BYTES, stream, a); }
    const hipError_t le = hipPeekAtLastError();
    if (le != hipSuccess) fprintf(stderr, "kernel_launch: launch failed: %s\n", hipGetErrorName(le));
}
```
